# Optimizing an MI355X kernel written in HIP

```python
import math
import jax, jax.numpy as jnp
from jax import lax
import numpy as np

D_MODEL = 1024
BATCH = 8
SEQ = 4096
DEPTH = 2

CHUNK = 64
N_MEM = 256
MEM_HEADS = 4
MEM_HEAD_DIM = D_MODEL // MEM_HEADS
D_MIX = D_MODEL
POOL_WINDOWS = (2, 4, 8, 16)
POOL_WIDTH = D_MIX // 4
POOL_GROUP = POOL_WIDTH // len(POOL_WINDOWS)
QK_NOPE = 128
QK_ROPE = 64
V_HEAD = 128
MLA_HEADS = (D_MIX - POOL_WIDTH) // V_HEAD
Q_LORA = 256
KV_LORA = 128
ROPE_BASE = 10000.0
D_FF = 2816
Q_BLOCK = 128
D_IN = POOL_WIDTH + Q_LORA + KV_LORA + QK_ROPE
ALPHA = (2 * DEPTH) ** 0.25
BETA = (8 * DEPTH) ** -0.25
LN_EPS = 1e-5
RMS_EPS = 1e-6
NEG_INF = -1e30

kernel_name = 'hybrid_pool_mla_macaron_deepnorm'


def layer_norm(x, g, b):
    xf = x.astype(jnp.float32)
    mu = jnp.mean(xf, axis=-1, keepdims=True)
    var = jnp.mean(jnp.square(xf - mu), axis=-1, keepdims=True)
    y = (xf - mu) * lax.rsqrt(var + LN_EPS) * g.astype(jnp.float32) + b.astype(jnp.float32)
    return y.astype(x.dtype)


def rms_norm(x, g):
    xf = x.astype(jnp.float32)
    y = xf * lax.rsqrt(jnp.mean(jnp.square(xf), axis=-1, keepdims=True) + RMS_EPS)
    return (y * g.astype(jnp.float32)).astype(x.dtype)


def swiglu(x, w13, w2):
    gate, up = jnp.split(x @ w13, 2, axis=-1)
    return (jax.nn.silu(gate) * up) @ w2


def rope(x, positions):
    half = QK_ROPE // 2
    inv_freq = ROPE_BASE ** (-jnp.arange(half, dtype=jnp.float32) / half)
    ang = positions.astype(jnp.float32)[..., None] * inv_freq
    ang = ang.reshape(ang.shape[:2] + (1,) * (x.ndim - 3) + (half,))
    cos, sin = jnp.cos(ang), jnp.sin(ang)
    xf = x.astype(jnp.float32)
    x1, x2 = xf[..., :half], xf[..., half:]
    out = jnp.concatenate([x1 * cos - x2 * sin, x2 * cos + x1 * sin], axis=-1)
    return out.astype(x.dtype)


def pool_mixer(u, pool_w, pool_scale):
    B, S, _ = u.shape
    uf = u.astype(jnp.float32)
    cs = jnp.cumsum(uf, axis=1)
    t = jnp.arange(S)
    means = []
    for g, w in enumerate(POOL_WINDOWS):
        csg = cs[..., g * POOL_GROUP:(g + 1) * POOL_GROUP]
        prev = jnp.pad(csg[:, :S - w], ((0, 0), (w, 0), (0, 0)))
        cnt = jnp.minimum(t + 1, w).astype(jnp.float32)[None, :, None]
        means.append((csg - prev) / cnt)
    d = (jnp.concatenate(means, axis=-1) - uf).astype(u.dtype)
    d = d.reshape(B, S, len(POOL_WINDOWS), POOL_GROUP)
    y = jnp.einsum('bsgc,gcd->bsgd', d, pool_w).reshape(B, S, POOL_WIDTH)
    return y * pool_scale


def mla_mixer(c_q, c_kv, k_pe, positions, q_norm_g, w_uq, kv_norm_g, w_ukv):
    B, S, _ = c_q.shape
    H = MLA_HEADS
    q = (rms_norm(c_q, q_norm_g) @ w_uq).reshape(B, S, H, QK_NOPE + QK_ROPE)
    q = jnp.concatenate([q[..., :QK_NOPE], rope(q[..., QK_NOPE:], positions)], axis=-1)
    kv = (rms_norm(c_kv, kv_norm_g) @ w_ukv).reshape(B, S, H, QK_NOPE + V_HEAD)
    k_nope, v = kv[..., :QK_NOPE], kv[..., QK_NOPE:]
    k_rot = rope(k_pe, positions)
    k = jnp.concatenate([k_nope, jnp.broadcast_to(k_rot[:, :, None, :], (B, S, H, QK_ROPE))], axis=-1)
    scale = (QK_NOPE + QK_ROPE) ** -0.5
    nb = S // Q_BLOCK
    q_blocks = q.reshape(B, nb, Q_BLOCK, H, QK_NOPE + QK_ROPE).transpose(1, 0, 2, 3, 4)
    q_idx = jnp.arange(S).reshape(nb, Q_BLOCK)
    k_chunk = jnp.arange(S) // CHUNK

    def attend(args):
        qb, qi = args
        s = jnp.einsum('bqhd,bkhd->bhqk', qb, k, preferred_element_type=jnp.float32) * scale
        mask = (qi[:, None] // CHUNK) >= k_chunk[None, :]
        s = jnp.where(mask[None, None], s, NEG_INF)
        p = jax.nn.softmax(s, axis=-1).astype(v.dtype)
        return jnp.einsum('bhqk,bkhd->bqhd', p, v)

    o = lax.map(attend, (q_blocks, q_idx))
    return o.transpose(1, 0, 2, 3, 4).reshape(B, S, H * V_HEAD)


def memory_cross_attention(x, mem, wq, wkv, wo):
    B, S, _ = x.shape
    q = (x @ wq).reshape(B, S, MEM_HEADS, MEM_HEAD_DIM)
    k, v = jnp.split(mem @ wkv, 2, axis=-1)
    k = k.reshape(B, mem.shape[1], MEM_HEADS, MEM_HEAD_DIM)
    v = v.reshape(B, mem.shape[1], MEM_HEADS, MEM_HEAD_DIM)
    s = jnp.einsum('bshd,bmhd->bhsm', q, k, preferred_element_type=jnp.float32) * MEM_HEAD_DIM ** -0.5
    p = jax.nn.softmax(s, axis=-1).astype(v.dtype)
    o = jnp.einsum('bhsm,bmhd->bshd', p, v).reshape(B, S, D_MODEL)
    return o @ wo


def setup_inputs(seed: int = 0) -> dict:
    key = jax.random.key(seed)
    ks = jax.random.split(key, 24)

    def nrm(k, shape, scale):
        return jax.random.normal(k, shape, jnp.float32) * scale

    x = nrm(ks[0], (BATCH, SEQ, D_MODEL), 1.0)
    mem = nrm(ks[1], (BATCH, N_MEM, D_MODEL), 1.0)
    start = jax.random.randint(ks[2], (BATCH, 1), 0, 8192, dtype=jnp.int32)
    positions = (start + jnp.arange(SEQ, dtype=jnp.int32)[None, :]).astype(jnp.int32)
    L = DEPTH
    return {
        'x': x,
        'mem': mem,
        'positions': positions,
        'ln_g': 1.0 + nrm(ks[3], (L, 4, D_MODEL), 0.05),
        'ln_b': nrm(ks[4], (L, 4, D_MODEL), 0.02),
        'ffn1_w13': nrm(ks[5], (L, D_MODEL, 2 * D_FF), D_MODEL ** -0.5),
        'ffn1_w2': nrm(ks[6], (L, D_FF, D_MODEL), BETA * D_FF ** -0.5),
        'w_in': nrm(ks[7], (L, D_MODEL, D_IN), D_MODEL ** -0.5),
        'pool_w': nrm(ks[8], (L, len(POOL_WINDOWS), POOL_GROUP, POOL_GROUP), POOL_GROUP ** -0.5),
        'pool_scale': 1.0 + nrm(ks[9], (L, POOL_WIDTH), 0.1),
        'q_norm_g': 1.0 + nrm(ks[10], (L, Q_LORA), 0.05),
        'w_uq': nrm(ks[11], (L, Q_LORA, MLA_HEADS * (QK_NOPE + QK_ROPE)), Q_LORA ** -0.5),
        'kv_norm_g': 1.0 + nrm(ks[12], (L, KV_LORA), 0.05),
        'w_ukv': nrm(ks[13], (L, KV_LORA, MLA_HEADS * (QK_NOPE + V_HEAD)), KV_LORA ** -0.5),
        'w_out': nrm(ks[14], (L, D_MIX, D_MODEL), BETA * D_MIX ** -0.5),
        'mem_wq': nrm(ks[15], (L, D_MODEL, D_MODEL), D_MODEL ** -0.5),
        'mem_wkv': nrm(ks[16], (L, D_MODEL, 2 * D_MODEL), D_MODEL ** -0.5),
        'mem_wo': nrm(ks[17], (L, D_MODEL, D_MODEL), BETA * D_MODEL ** -0.5),
        'ffn2_w13': nrm(ks[18], (L, D_MODEL, 2 * D_FF), D_MODEL ** -0.5),
        'ffn2_w2': nrm(ks[19], (L, D_FF, D_MODEL), BETA * D_FF ** -0.5),
    }


def reference(x, mem, positions, ln_g, ln_b, ffn1_w13, ffn1_w2, w_in, pool_w, pool_scale,
              q_norm_g, w_uq, kv_norm_g, w_ukv, w_out, mem_wq, mem_wkv, mem_wo,
              ffn2_w13, ffn2_w2):
    for l in range(DEPTH):
        x = layer_norm(ALPHA * x + 0.5 * swiglu(x, ffn1_w13[l], ffn1_w2[l]), ln_g[l, 0], ln_b[l, 0])
        h = x @ w_in[l]
        o0 = POOL_WIDTH
        o1 = o0 + Q_LORA
        o2 = o1 + KV_LORA
        u_pool, c_q, c_kv, k_pe = h[..., :o0], h[..., o0:o1], h[..., o1:o2], h[..., o2:]
        y_pool = pool_mixer(u_pool, pool_w[l], pool_scale[l])
        y_mla = mla_mixer(c_q, c_kv, k_pe, positions, q_norm_g[l], w_uq[l],
                          kv_norm_g[l], w_ukv[l])
        y_mix = jnp.concatenate([y_pool, y_mla], axis=-1) @ w_out[l]
        x = layer_norm(ALPHA * x + y_mix, ln_g[l, 1], ln_b[l, 1])
        y_mem = memory_cross_attention(x, mem, mem_wq[l], mem_wkv[l], mem_wo[l])
        x = layer_norm(ALPHA * x + y_mem, ln_g[l, 2], ln_b[l, 2])
        x = layer_norm(ALPHA * x + 0.5 * swiglu(x, ffn2_w13[l], ffn2_w2[l]), ln_g[l, 3], ln_b[l, 3])
    return x
```

```cpp
#include <hip/hip_runtime.h>
#include <hip/hip_cooperative_groups.h>
#include <cstdio>
#include <cstdint>
#include <cmath>
namespace cg = cooperative_groups;
namespace pg8 {
#define PG8_LAS __attribute__((address_space(3)))
typedef unsigned short bf16_t;
typedef short bf16x8 __attribute__((ext_vector_type(8)));
typedef float f32x4 __attribute__((ext_vector_type(4)));
typedef unsigned u32x4 __attribute__((ext_vector_type(4)));
constexpr int BM = 256, BK = 64, HALF = 128, HTB = HALF * BK * 2  , STAGE_BYTES = 8 * HTB, NXCD = 8, WGM = 8;

__host__ __device__ __forceinline__ int lds_byte(int r, int c) { const int st = (r >> 4) * 2 + (c >> 5), rr = r & 15, cc = c & 31, ob = rr * 64 + cc * 2; return st * 1024 + (ob ^ (((ob >> 9) & 1) << 5)); }
__host__ __device__ __forceinline__ void stage_rc(int b, int& R, int& C) { const int st = b / 1024, sb = b % 1024, swz = sb ^ (((sb >> 9) & 1) << 5); R = (st >> 1) * 16 + swz / 64; C = (st & 1) * 32 + (swz % 64) / 2; }
__host__ __device__ __forceinline__ int perm32(int rho) { const int n = rho >> 4, i = rho & 15; return 8 * (i >> 2) + 4 * n + (i & 3); }

struct Unit { int pm, pn; };
struct Gemm { const bf16_t* A; const bf16_t* Bt; int M, N, K; };

struct StaticOrder {
    int nM, nN, nwg, G, c;
    __host__ __device__ void init(int M, int N, int G_, int c_) { nM = M / BM; nN = N / BM; nwg = nM * nN; G = G_; c = c_; }
    __host__ __device__ bool next(int i, Unit& u) const {
        const long L = (long)i * G + c; if (L >= nwg) return false;
        int wgid = (int)L; { const int q = nwg / NXCD, r = nwg % NXCD, xcd = wgid % NXCD, off = wgid / NXCD; wgid = (xcd < r ? xcd * (q + 1) : r * (q + 1) + (xcd - r) * q) + off; }
        const int nig = WGM * nN, gid = wgid / nig, fm = gid * WGM, gsz = (nM - fm) < WGM ? (nM - fm) : WGM;
        u.pm = fm + ((wgid % nig) % gsz); u.pn = (wgid % nig) / gsz; return true;
    }
    __device__ __forceinline__ void a_ready(const Unit&) const {}
    __device__ __forceinline__ void done(const Unit&) const {}
};

typedef float f32x2 __attribute__((ext_vector_type(2)));
typedef __bf16 bf16x2_t __attribute__((ext_vector_type(2)));
__device__ __forceinline__ unsigned cvt_pk_bf16(float lo, float hi) { f32x2 v = {lo, hi}; bf16x2_t b = __builtin_convertvector(v, bf16x2_t); return __builtin_bit_cast(unsigned, b); }

struct EpiBf16 {
    static constexpr bool PERM = true, AFTER_DRAIN = false;
    bf16_t* O; int ldc;
    __device__ __forceinline__ void operator()(const f32x4 (&acc)[2][2][4][2], const Unit& u, int wr, int wc, int fr, int fq) const {
        const int row0 = u.pm * BM + wr * 64 + fr, col0 = u.pn * BM + wc * 32 + 8 * fq;
#pragma unroll
        for (int ai = 0; ai < 2; ++ai)
#pragma unroll
            for (int m = 0; m < 4; ++m) { bf16_t* rowp = O + (size_t)(row0 + ai * HALF + m * 16) * ldc + col0;
#pragma unroll
                for (int bj = 0; bj < 2; ++bj) { const f32x4 v0 = acc[ai][bj][m][0], v1 = acc[ai][bj][m][1];
                    u32x4 w; w.x = cvt_pk_bf16(v0[0], v0[1]); w.y = cvt_pk_bf16(v0[2], v0[3]); w.z = cvt_pk_bf16(v1[0], v1[1]); w.w = cvt_pk_bf16(v1[2], v1[3]);
                    *(u32x4*)(rowp + bj * HALF) = w; } }
    }
};
struct EpiSwiGLU {
    static constexpr bool PERM = true, AFTER_DRAIN = false;
    bf16_t* O; int ldc;
    __device__ __forceinline__ void operator()(const f32x4 (&acc)[2][2][4][2], const Unit& u, int wr, int wc, int fr, int fq) const {
        const int row0 = u.pm * BM + wr * 64 + fr, col0 = u.pn * HALF + wc * 32 + 8 * fq;
#pragma unroll
        for (int ai = 0; ai < 2; ++ai)
#pragma unroll
            for (int m = 0; m < 4; ++m) { bf16_t* rowp = O + (size_t)(row0 + ai * HALF + m * 16) * ldc + col0;
                float h[8];
#pragma unroll
                for (int n = 0; n < 2; ++n)
#pragma unroll
                    for (int j = 0; j < 4; ++j) { const float g = acc[ai][0][m][n][j], up = acc[ai][1][m][n][j];
                        const float sg = __builtin_amdgcn_rcpf(1.0f + __builtin_amdgcn_exp2f(-1.4426950408889634f * g));
                        h[n * 4 + j] = g * sg * up; }
                u32x4 w; w.x = cvt_pk_bf16(h[0], h[1]); w.y = cvt_pk_bf16(h[2], h[3]); w.z = cvt_pk_bf16(h[4], h[5]); w.w = cvt_pk_bf16(h[6], h[7]);
                *(u32x4*)rowp = w; }
    }
};
struct EpiRes {
    static constexpr bool PERM = false, AFTER_DRAIN = false;
    const float* X; float* Y; int ldc; float alpha, s;
    __device__ __forceinline__ void operator()(const f32x4 (&acc)[2][2][4][2], const Unit& u, int wr, int wc, int fr, int fq) const {
        const int col0 = u.pn * BM + wc * 32 + 4 * fq;
#pragma unroll
        for (int ai = 0; ai < 2; ++ai)
#pragma unroll
            for (int m = 0; m < 4; ++m) { const size_t off = (size_t)(u.pm * BM + ai * HALF + wr * 64 + m * 16 + fr) * ldc + col0;
#pragma unroll
                for (int bj = 0; bj < 2; ++bj)
#pragma unroll
                    for (int n = 0; n < 2; ++n) { const f32x4 xv = *(const f32x4*)(X + off + bj * HALF + n * 16);
                        *(f32x4*)(Y + off + bj * HALF + n * 16) = xv * alpha + acc[ai][bj][m][n] * s; } }
    }
};
struct EpiF32 {
    static constexpr bool PERM = false, AFTER_DRAIN = false;
    float* O; int ldc;
    __device__ __forceinline__ void operator()(const f32x4 (&acc)[2][2][4][2], const Unit& u, int wr, int wc, int fr, int fq) const {
        const int col0 = u.pn * BM + wc * 32 + 4 * fq;
#pragma unroll
        for (int ai = 0; ai < 2; ++ai)
#pragma unroll
            for (int m = 0; m < 4; ++m) { const size_t off = (size_t)(u.pm * BM + ai * HALF + wr * 64 + m * 16 + fr) * ldc + col0;
#pragma unroll
                for (int bj = 0; bj < 2; ++bj)
#pragma unroll
                    for (int n = 0; n < 2; ++n) *(f32x4*)(O + off + bj * HALF + n * 16) = acc[ai][bj][m][n]; }
    }
};
template <class Epi, class Sched, bool ALIGN_EPI = false, bool SP2 = false>
__device__ __forceinline__ void gemm_phase(PG8_LAS unsigned char* lds, const Gemm g, const Sched& S, const Epi& E) {
    int tid = threadIdx.x; asm volatile("" : "+v"(tid));
    const int wid = __builtin_amdgcn_readfirstlane(tid >> 6), lane = tid & 63, wr = wid >> 2, wc = wid & 3, fr = lane & 15, fq = lane >> 4;
    const int K = g.K, nt = K / BK;
    unsigned voffA[2], voffB[2];
#pragma unroll
    for (int i = 0; i < 2; ++i) { int R, C; stage_rc(tid * 16 + i * 8192, R, C); const int Rb = Epi::PERM ? ((R & ~31) + perm32(R & 31)) : R;
        voffA[i] = (unsigned)(R * K + C) * 2u; voffB[i] = (unsigned)(Rb * K + C) * 2u; }
    const size_t kstep = (size_t)(BK * 2);
    const size_t hstep = (size_t)HALF * K * 2;
    const size_t tstep = 2 * hstep;
    const unsigned ldsw = (unsigned)wid * 1024u;
    const int aoff = lds_byte(wr * 64 + fr, fq * 8), boff = lds_byte(wc * 32 + fr, fq * 8);
#define PG8_SA(b, h) (((b) * 2 + (h)) * HTB)
#define PG8_SB(b, h) ((4 + (b) * 2 + (h)) * HTB)
#define PG8_STAGE(bufoff, gbase, voff) do { _Pragma("unroll") for (int _i = 0; _i < 2; ++_i) \
        __builtin_amdgcn_global_load_lds((const unsigned*)((const char*)(gbase) + (voff)[_i]), (PG8_LAS unsigned*)(lds + (bufoff) + ldsw + _i * 8192), 16, 0, 0); } while (0)
#define PG8_LDA(dst, b, h) do { _Pragma("unroll") for (int m = 0; m < 4; ++m) _Pragma("unroll") for (int k = 0; k < 2; ++k) dst[m][k] = *(const PG8_LAS bf16x8*)(lds + PG8_SA(b, h) + aoff + m * 2048 + k * 1024); } while (0)
#define PG8_LDB(dst, b, h) do { _Pragma("unroll") for (int n = 0; n < 2; ++n) _Pragma("unroll") for (int k = 0; k < 2; ++k) dst[n][k] = *(const PG8_LAS bf16x8*)(lds + PG8_SB(b, h) + boff + n * 2048 + k * 1024); } while (0)
#define PG8_MMA(ai, bj, At, Bt) do { __builtin_amdgcn_s_setprio(1); _Pragma("unroll") for (int m = 0; m < 4; ++m) _Pragma("unroll") for (int n = 0; n < 2; ++n) _Pragma("unroll") for (int k = 0; k < 2; ++k) \
        acc[ai][bj][m][n] = __builtin_amdgcn_mfma_f32_16x16x32_bf16(Bt[n][k], At[m][k], acc[ai][bj][m][n], 0, 0, 0); __builtin_amdgcn_s_setprio(0); } while (0)
#define PG8_WAIT_V(n) asm volatile("s_waitcnt vmcnt(" #n ")" ::: "memory")
#define PG8_WAIT_L(n) asm volatile("s_waitcnt lgkmcnt(" #n ")" ::: "memory")
#define PG8_BAR __builtin_amdgcn_s_barrier()
#define PG8_SCHED __builtin_amdgcn_sched_barrier(0)
    Unit cur, nxt; int ui = 0;
    if (!S.next(0, cur)) return;
    f32x4 acc[2][2][4][2];
#pragma unroll
    for (int a = 0; a < 2; ++a)
#pragma unroll
        for (int b = 0; b < 2; ++b)
#pragma unroll
            for (int m = 0; m < 4; ++m)
#pragma unroll
                for (int n = 0; n < 2; ++n) acc[a][b][m][n] = (f32x4){0.f, 0.f, 0.f, 0.f};
    bf16x8 At[4][2], B0[2][2], B1[2][2];
    const char* cA = (const char*)g.A + (size_t)cur.pm * tstep; const char* cB = (const char*)g.Bt + (size_t)cur.pn * tstep;
    S.a_ready(cur);
    if constexpr (SP2) {
        PG8_STAGE(PG8_SB(0, 0), cB, voffB); PG8_STAGE(PG8_SB(0, 1), cB + hstep, voffB); PG8_STAGE(PG8_SA(0, 0), cA, voffA); PG8_STAGE(PG8_SA(0, 1), cA + hstep, voffA);
        if (wr == 1) PG8_BAR;
        PG8_WAIT_V(2); PG8_BAR;
        PG8_STAGE(PG8_SB(1, 0), cB + kstep, voffB); PG8_STAGE(PG8_SA(1, 0), cA + kstep, voffA); PG8_STAGE(PG8_SB(1, 1), cB + hstep + kstep, voffB);
        PG8_WAIT_V(6); PG8_BAR;
    } else {
        PG8_STAGE(PG8_SB(0, 0), cB, voffB); PG8_STAGE(PG8_SA(0, 0), cA, voffA); PG8_STAGE(PG8_SB(0, 1), cB + hstep, voffB); PG8_STAGE(PG8_SA(0, 1), cA + hstep, voffA);
        if (wr == 1) PG8_BAR;
        PG8_WAIT_V(4); PG8_BAR;
        PG8_STAGE(PG8_SB(1, 0), cB + kstep, voffB); PG8_STAGE(PG8_SA(1, 0), cA + kstep, voffA); PG8_STAGE(PG8_SB(1, 1), cB + hstep + kstep, voffB);
        PG8_WAIT_V(6); PG8_BAR;
    }
    for (;;) {
        const bool has_next = S.next(ui + 1, nxt);
        const char* nA = has_next ? (const char*)g.A + (size_t)nxt.pm * tstep : cA; const char* nB = has_next ? (const char*)g.Bt + (size_t)nxt.pn * tstep : cB;
        for (int t = 0; t < nt; t += 2) {
            const bool last = (t == nt - 2);
            const char* a1 = cA + (size_t)(t + 1) * kstep;
            const char* a2 = last ? nA : cA + (size_t)(t + 2) * kstep; const char* b2 = last ? nB : cB + (size_t)(t + 2) * kstep;
            const char* a3 = a2 + kstep; const char* b3 = b2 + kstep;
            if (last && has_next) S.a_ready(nxt);
            if constexpr (SP2) {
            PG8_LDB(B0, 0, 0); PG8_LDB(B1, 0, 1); PG8_SCHED; PG8_LDA(At, 0, 0); PG8_STAGE(PG8_SA(1, 1), a1 + hstep, voffA);
            PG8_WAIT_V(8); PG8_WAIT_L(0); PG8_BAR; PG8_MMA(0, 0, At, B0); PG8_MMA(0, 1, At, B1); PG8_BAR; PG8_SCHED;
            PG8_LDA(At, 0, 1); PG8_STAGE(PG8_SB(0, 0), b2, voffB); PG8_STAGE(PG8_SB(0, 1), b2 + hstep, voffB); PG8_STAGE(PG8_SA(0, 0), a2, voffA);
            PG8_WAIT_V(8); PG8_WAIT_L(0); PG8_BAR; PG8_MMA(1, 0, At, B0); PG8_MMA(1, 1, At, B1); PG8_BAR; PG8_SCHED;
            PG8_LDB(B0, 1, 0); PG8_LDB(B1, 1, 1); PG8_SCHED; PG8_LDA(At, 1, 0); PG8_STAGE(PG8_SA(0, 1), a2 + hstep, voffA);
            PG8_WAIT_V(8); PG8_WAIT_L(0); PG8_BAR; PG8_MMA(0, 0, At, B0); PG8_MMA(0, 1, At, B1); PG8_BAR; PG8_SCHED;
            PG8_LDA(At, 1, 1); PG8_STAGE(PG8_SB(1, 0), b3, voffB); PG8_STAGE(PG8_SB(1, 1), b3 + hstep, voffB); PG8_STAGE(PG8_SA(1, 0), a3, voffA);
            PG8_WAIT_V(8); PG8_WAIT_L(0); PG8_BAR; PG8_MMA(1, 0, At, B0); PG8_MMA(1, 1, At, B1); PG8_BAR; PG8_SCHED;
            } else {
            PG8_LDB(B0, 0, 0); PG8_SCHED; PG8_LDA(At, 0, 0); PG8_STAGE(PG8_SA(1, 1), a1 + hstep, voffA);
            PG8_WAIT_L(8); PG8_BAR; PG8_WAIT_L(0); PG8_MMA(0, 0, At, B0); PG8_BAR; PG8_SCHED;
            PG8_LDB(B1, 0, 1); PG8_STAGE(PG8_SB(0, 0), b2, voffB);
            PG8_BAR; PG8_WAIT_L(0); PG8_MMA(0, 1, At, B1); PG8_BAR;
            PG8_LDA(At, 0, 1); PG8_STAGE(PG8_SA(0, 0), a2, voffA);
            PG8_BAR; PG8_WAIT_L(0); PG8_MMA(1, 0, At, B0); PG8_BAR; PG8_SCHED;
            PG8_STAGE(PG8_SB(0, 1), b2 + hstep, voffB);
            PG8_WAIT_V(6); PG8_BAR; PG8_MMA(1, 1, At, B1); PG8_BAR;
            PG8_LDB(B0, 1, 0); PG8_SCHED; PG8_LDA(At, 1, 0); PG8_STAGE(PG8_SA(0, 1), a2 + hstep, voffA);
            PG8_WAIT_L(8); PG8_BAR; PG8_WAIT_L(0); PG8_MMA(0, 0, At, B0); PG8_BAR; PG8_SCHED;
            PG8_LDB(B1, 1, 1); PG8_STAGE(PG8_SB(1, 0), b3, voffB);
            PG8_BAR; PG8_WAIT_L(0); PG8_MMA(0, 1, At, B1); PG8_BAR;
            PG8_LDA(At, 1, 1); PG8_STAGE(PG8_SA(1, 0), a3, voffA);
            PG8_BAR; PG8_WAIT_L(0); PG8_MMA(1, 0, At, B0); PG8_BAR; PG8_SCHED;
            PG8_STAGE(PG8_SB(1, 1), b3 + hstep, voffB);
            PG8_WAIT_V(6); PG8_BAR; PG8_MMA(1, 1, At, B1); PG8_BAR;
            }
        }
        if constexpr (ALIGN_EPI) { if (wr == 0) PG8_BAR; }
        if constexpr (!Epi::AFTER_DRAIN) { E(acc, cur, wr, wc, fr, fq); S.done(cur); }
        if (!has_next) break;
#pragma unroll
        for (int a = 0; a < 2; ++a)
#pragma unroll
            for (int b = 0; b < 2; ++b)
#pragma unroll
                for (int m = 0; m < 4; ++m)
#pragma unroll
                    for (int n = 0; n < 2; ++n) acc[a][b][m][n] = (f32x4){0.f, 0.f, 0.f, 0.f};
        cur = nxt; cA = nA; cB = nB; ++ui;
        if constexpr (ALIGN_EPI) { if (wr == 1) PG8_BAR; }
    }
    PG8_WAIT_V(0);
    if constexpr (!ALIGN_EPI) { if (wr == 0) PG8_BAR; }
    PG8_BAR;
    if constexpr (Epi::AFTER_DRAIN) { E.fused(acc, cur, wr, wc, fr, fq, lds, wid, lane); S.done(cur); }
#undef PG8_SA
#undef PG8_SB
#undef PG8_STAGE
#undef PG8_LDA
#undef PG8_LDB
#undef PG8_MMA
#undef PG8_WAIT_V
#undef PG8_WAIT_L
#undef PG8_BAR
#undef PG8_SCHED
}
}

constexpr int NB = 8, SEQ = 4096, DM = 1024, MTOK = NB * SEQ, DFF = 2816, NMEM = 256, NLAYER = 2;
constexpr int NHEAD = 6, DQK = 192, DV = 128, QW = NHEAD * DQK  , QP = 1280, KNW = NHEAD * 128  , HINW = 768;
constexpr float ALPHA_F = 1.4142135623730951f;
constexpr float LOG2E = 1.4426950408889634f;
constexpr int NWAVES = 8, NTHREADS = 512;

#define LAS __attribute__((address_space(3)))
typedef unsigned short bf16_t;
typedef short bf16x8 __attribute__((ext_vector_type(8)));
typedef float f32x4 __attribute__((ext_vector_type(4)));
typedef float f32x16 __attribute__((ext_vector_type(16)));
typedef float f32x2v __attribute__((ext_vector_type(2)));
typedef unsigned u32x4 __attribute__((ext_vector_type(4)));
typedef unsigned u32x2 __attribute__((ext_vector_type(2)));

constexpr size_t MiB = 1u << 20;
constexpr size_t WS_CTL = 0, CTL_ZERO_BYTES = 64 * 1024;
constexpr size_t OW_13A = 0, SZ_13 = (size_t)2 * DFF * DM * 2, OW_2A = OW_13A + SZ_13, SZ_2 = (size_t)DM * DFF * 2, OW_13B = OW_2A + SZ_2, OW_2B = OW_13B + SZ_13,
    OW_IN = OW_2B + SZ_2, SZ_IN = (size_t)HINW * DM * 2, OW_UQ = OW_IN + SZ_IN, SZ_UQ = (size_t)1280 * 256 * 2, OW_K = OW_UQ + SZ_UQ, SZ_K = (size_t)KNW * 128 * 2,
    OW_V = OW_K + SZ_K, OW_POOL = OW_V + SZ_K, SZ_POOL = (size_t)256 * 256 * 2, OW_OUT = OW_POOL + SZ_POOL, SZ_SQ = (size_t)DM * DM * 2, OW_MQ = OW_OUT + SZ_SQ,
    OW_MK = OW_MQ + SZ_SQ, OW_MV = OW_MK + SZ_SQ, OW_MO = OW_MV + SZ_SQ, LW_USED = OW_MO + SZ_SQ, LW = 46 * MiB;
static_assert(LW_USED <= LW, "weights per layer");
constexpr size_t WS_W = 1 * MiB, WS_MEMB = WS_W + 2 * LW  , WS_MEMK = WS_MEMB + 4 * MiB, WS_MEMVT = WS_MEMK + 8 * MiB, WS_CS = WS_MEMVT + 8 * MiB,
    WS_XN = WS_CS + 8 * MiB  , WS_Y = WS_XN + 64 * MiB  , WS_SH = WS_Y + 128 * MiB  , WS_END = WS_SH + 176 * MiB  ;
constexpr size_t WS_VT = WS_XN, WS_HIN = WS_Y, WS_Q = WS_Y, WS_KN = WS_Y + 80 * MiB;
constexpr size_t WS_H = WS_SH, WS_CQN = WS_SH, WS_CKVN = WS_SH + 16 * MiB, WS_KROT = WS_SH + 24 * MiB, WS_DPOOL = WS_SH + 28 * MiB, WS_YCAT = WS_SH + 44 * MiB;
constexpr size_t WS_QC = WS_SH, WS_OC = WS_SH + 64 * MiB;
static_assert((size_t)MTOK * QP * 2 <= 80 * MiB && WS_KN + (size_t)MTOK * KNW * 2 <= WS_SH && (size_t)MTOK * HINW * 4 <= 96 * MiB && WS_YCAT + (size_t)MTOK * DM * 2 <= WS_END && (size_t)MTOK * DFF * 2 <= 176 * MiB, "ws map");
constexpr int CW_QUEUE = 0, CW_BAR = 4096;

constexpr int RING_BYTES = 131072, MISC_OFF = RING_BYTES + 320, LDS_BYTES = 147456;

struct Params {
    const float* x; const float* mem; const int* pos; const float* ln_g; const float* ln_b; const float* ffn1_w13; const float* ffn1_w2; const float* w_in; const float* pool_w;
    const float* pool_scale; const float* q_norm_g; const float* w_uq; const float* kv_norm_g; const float* w_ukv; const float* w_out; const float* mem_wq; const float* mem_wkv;
    const float* mem_wo; const float* ffn2_w13; const float* ffn2_w2; float* out; unsigned char* ws;
};

__device__ __forceinline__ unsigned f2bf(float f) { unsigned u = __builtin_bit_cast(unsigned, f); return (u + 0x7fffu + ((u >> 16) & 1u)) >> 16; }
__device__ __forceinline__ unsigned pk2(float lo, float hi) { return f2bf(lo) | (f2bf(hi) << 16); }
__device__ __forceinline__ float wave_sum(float v) {
#pragma unroll
    for (int o = 1; o < 64; o <<= 1) v += __shfl_xor(v, o);
    return v;
}

enum { MAP_ID = 0, MAP_SWIGLU, MAP_WIN, MAP_WUQ, MAP_WK, MAP_WV, MAP_OFF1024 };
__device__ __forceinline__ int map_src(int kind, int n) {
    switch (kind) {
        case MAP_SWIGLU: { const int pn = n >> 8, bj = (n >> 7) & 1, c = n & 127; return bj * DFF + pn * 128 + c; }
        case MAP_WIN: { if (n < 640) return n; if (n >= 704) return -1; const int rho = n - 640; return 640 + (rho & 1) * 32 + (rho >> 1); }
        case MAP_WUQ: { if (n >= QW) return -1; const int hd = n / DQK, d = n % DQK; if (d < 128) return n; const int rho = d - 128; return hd * DQK + 128 + (rho & 1) * 32 + (rho >> 1); }
        case MAP_WK: { const int hd = n >> 7, d = n & 127; return hd * 256 + d; }
        case MAP_WV: { const int hd = n >> 7, d = n & 127; return hd * 256 + 128 + d; }
        case MAP_OFF1024: return n + 1024;
        default: return n;
    }
}
__device__ __forceinline__ void cvt_item(const float* W, int K, int Nsrc, bf16_t* WT, int nblk, int kind, const float* kscale, float scal, LAS float* scr, int item, int lane) {
    const int kb = item / nblk, nb = item % nblk, k0 = 64 * kb, n0 = 32 * nb;
    const int src = map_src(kind, n0 + (lane & 31));
#pragma unroll 8
    for (int i = 0; i < 32; ++i) { const int kk = 2 * i + (lane >> 5); float v = 0.f;
        if (src >= 0) { v = W[(size_t)(k0 + kk) * Nsrc + src] * scal; if (kscale) v *= kscale[k0 + kk]; }
        scr[kk * 33 + (lane & 31)] = v; }
    asm volatile("s_waitcnt lgkmcnt(0)" ::: "memory");
    const int c = lane & 7;
#pragma unroll
    for (int j = 0; j < 4; ++j) { const int n = (lane >> 3) + 8 * j; const LAS float* s = scr + (8 * c) * 33 + n;
        u32x4 o; o.x = pk2(s[0 * 33], s[1 * 33]); o.y = pk2(s[2 * 33], s[3 * 33]); o.z = pk2(s[4 * 33], s[5 * 33]); o.w = pk2(s[6 * 33], s[7 * 33]);
        *(u32x4*)(WT + (size_t)(n0 + n) * K + k0 + 8 * c) = o; }
    asm volatile("s_waitcnt lgkmcnt(0)" ::: "memory");
}

constexpr int IT_13 = 16 * 176, IT_2 = 44 * 32, IT_IN = 16 * 24, IT_UQ = 4 * 40, IT_K = 2 * 24, IT_SQ = 16 * 32;
constexpr int IT_LAYER = 2 * IT_13 + 2 * IT_2 + IT_IN + IT_UQ + 2 * IT_K + 5 * IT_SQ;

__device__ __forceinline__ void prologue(const Params& P, LAS unsigned char* lds, int gw, int NGW, int wave, int lane) {
    LAS float* scr = (LAS float*)(lds + wave * 16384);
    unsigned char* ws = P.ws;
    for (int it = gw; it < NLAYER * IT_LAYER; it += NGW) {
        const int l = it / IT_LAYER; int r = it % IT_LAYER; unsigned char* wl = ws + WS_W + (size_t)l * LW;
        if (r < IT_13) { cvt_item(P.ffn1_w13 + (size_t)l * DM * 2 * DFF, DM, 2 * DFF, (bf16_t*)(wl + OW_13A), 176, MAP_SWIGLU, nullptr, 1.f, scr, r, lane); continue; } r -= IT_13;
        if (r < IT_2) { cvt_item(P.ffn1_w2 + (size_t)l * DFF * DM, DFF, DM, (bf16_t*)(wl + OW_2A), 32, MAP_ID, nullptr, 1.f, scr, r, lane); continue; } r -= IT_2;
        if (r < IT_13) { cvt_item(P.ffn2_w13 + (size_t)l * DM * 2 * DFF, DM, 2 * DFF, (bf16_t*)(wl + OW_13B), 176, MAP_SWIGLU, nullptr, 1.f, scr, r, lane); continue; } r -= IT_13;
        if (r < IT_2) { cvt_item(P.ffn2_w2 + (size_t)l * DFF * DM, DFF, DM, (bf16_t*)(wl + OW_2B), 32, MAP_ID, nullptr, 1.f, scr, r, lane); continue; } r -= IT_2;
        if (r < IT_IN) { cvt_item(P.w_in + (size_t)l * DM * 704, DM, 704, (bf16_t*)(wl + OW_IN), 24, MAP_WIN, nullptr, 1.f, scr, r, lane); continue; } r -= IT_IN;
        if (r < IT_UQ) { cvt_item(P.w_uq + (size_t)l * 256 * QW, 256, QW, (bf16_t*)(wl + OW_UQ), 40, MAP_WUQ, P.q_norm_g + l * 256, 0.07216878364870322f * LOG2E, scr, r, lane); continue; } r -= IT_UQ;
        if (r < IT_K) { cvt_item(P.w_ukv + (size_t)l * 128 * 1536, 128, 1536, (bf16_t*)(wl + OW_K), 24, MAP_WK, P.kv_norm_g + l * 128, 1.f, scr, r, lane); continue; } r -= IT_K;
        if (r < IT_K) { cvt_item(P.w_ukv + (size_t)l * 128 * 1536, 128, 1536, (bf16_t*)(wl + OW_V), 24, MAP_WV, P.kv_norm_g + l * 128, 1.f, scr, r, lane); continue; } r -= IT_K;
        if (r < IT_SQ) { cvt_item(P.w_out + (size_t)l * DM * DM, DM, DM, (bf16_t*)(wl + OW_OUT), 32, MAP_ID, nullptr, 1.f, scr, r, lane); continue; } r -= IT_SQ;
        if (r < IT_SQ) { cvt_item(P.mem_wq + (size_t)l * DM * DM, DM, DM, (bf16_t*)(wl + OW_MQ), 32, MAP_ID, nullptr, 0.0625f * LOG2E, scr, r, lane); continue; } r -= IT_SQ;
        if (r < IT_SQ) { cvt_item(P.mem_wkv + (size_t)l * DM * 2 * DM, DM, 2 * DM, (bf16_t*)(wl + OW_MK), 32, MAP_ID, nullptr, 1.f, scr, r, lane); continue; } r -= IT_SQ;
        if (r < IT_SQ) { cvt_item(P.mem_wkv + (size_t)l * DM * 2 * DM, DM, 2 * DM, (bf16_t*)(wl + OW_MV), 32, MAP_OFF1024, nullptr, 1.f, scr, r, lane); continue; } r -= IT_SQ;
        cvt_item(P.mem_wo + (size_t)l * DM * DM, DM, DM, (bf16_t*)(wl + OW_MO), 32, MAP_ID, nullptr, 1.f, scr, r, lane);
    }
    const int gt = gw * 64 + lane, NGT = NGW * 64;
    for (int idx = gt; idx < NLAYER * 65536; idx += NGT) { const int l = idx >> 16, n = (idx >> 8) & 255, k = idx & 255; float v = 0.f;
        if ((n >> 6) == (k >> 6)) v = P.pool_w[(size_t)l * 16384 + (n >> 6) * 4096 + (k & 63) * 64 + (n & 63)] * P.pool_scale[l * 256 + n];
        ((bf16_t*)(ws + WS_W + (size_t)l * LW + OW_POOL))[n * 256 + k] = (bf16_t)f2bf(v); }
    { const f32x4* xs = (const f32x4*)P.x; u32x2* xd = (u32x2*)(ws + WS_XN);
      for (size_t i = gt; i < (size_t)MTOK * DM / 4; i += NGT) { const f32x4 v = xs[i]; u32x2 o; o.x = pk2(v[0], v[1]); o.y = pk2(v[2], v[3]); xd[i] = o; }
      const f32x4* ms = (const f32x4*)P.mem; u32x2* md = (u32x2*)(ws + WS_MEMB);
      for (size_t i = gt; i < (size_t)NB * NMEM * DM / 4; i += NGT) { const f32x4 v = ms[i]; u32x2 o; o.x = pk2(v[0], v[1]); o.y = pk2(v[2], v[3]); md[i] = o; } }
    { float* cs = (float*)(ws + WS_CS);
      for (int idx = gt; idx < MTOK * 32; idx += NGT) { const int m = idx >> 5, i = idx & 31;
        const float inv = (float)exp2(-(double)i * (13.287712379549449 / 32.0));
        const float ang = (float)P.pos[m] * inv;
        const double a = (double)ang; const double kq = rint(a * 0.15915494309189535); const double rr = fma(-kq, 6.283185307179586, a) - kq * 2.4492935982947064e-16;
        const float rf = (float)rr;
        f32x2v o; o.x = cosf(rf); o.y = sinf(rf); *(f32x2v*)(cs + (size_t)idx * 2) = o; } }
}

__device__ __forceinline__ void ln_pass(const float* Y, const float* g, const float* b, float* X, bf16_t* XN, int gw, int NGW, int lane) {
    f32x4 gv[4], bv[4];
#pragma unroll
    for (int j = 0; j < 4; ++j) { gv[j] = *(const f32x4*)(g + 256 * j + 4 * lane); bv[j] = *(const f32x4*)(b + 256 * j + 4 * lane); }
    for (int m = gw; m < MTOK; m += NGW) {
        const f32x4* yr = (const f32x4*)(Y + (size_t)m * DM) + lane; f32x4 v[4]; float s = 0.f;
#pragma unroll
        for (int j = 0; j < 4; ++j) { v[j] = yr[64 * j]; s += (v[j][0] + v[j][1]) + (v[j][2] + v[j][3]); }
        const float mean = wave_sum(s) * (1.f / DM); float s2 = 0.f;
#pragma unroll
        for (int j = 0; j < 4; ++j) { v[j] = v[j] - mean; s2 += (v[j][0] * v[j][0] + v[j][1] * v[j][1]) + (v[j][2] * v[j][2] + v[j][3] * v[j][3]); }
        const float rstd = 1.f / sqrtf(wave_sum(s2) * (1.f / DM) + 1e-5f);
        f32x4* xr = (f32x4*)(X + (size_t)m * DM) + lane; u32x2* nr = (u32x2*)(XN + (size_t)m * DM) + lane;
#pragma unroll
        for (int j = 0; j < 4; ++j) { const f32x4 o = v[j] * rstd * gv[j] + bv[j]; xr[64 * j] = o; u32x2 w; w.x = pk2(o[0], o[1]); w.y = pk2(o[2], o[3]); nr[64 * j] = w; }
    }
}
__device__ __forceinline__ void mid_pass(const float* HIN, const float* CS, bf16_t* DPOOL, bf16_t* CQN, bf16_t* CKVN, bf16_t* KROT, int gw, int NGW, int lane) {
    for (int m = gw; m < MTOK; m += NGW) {
        const int t = m & (SEQ - 1);
        const float* hr = HIN + (size_t)m * HINW;
        const f32x4 u = *(const f32x4*)(hr + 4 * lane), cq = *(const f32x4*)(hr + 256 + 4 * lane);
        f32x4 c2 = {0.f, 0.f, 0.f, 0.f}; if (lane < 48) c2 = *(const f32x4*)(hr + 512 + 4 * lane);
        { const int w = 2 << (lane >> 4); f32x4 a = u;
          for (int tau = 1; tau < 16; ++tau) if (tau < w && tau <= t) a += *(const f32x4*)(hr - (size_t)tau * HINW + 4 * lane);
          const float ic = 1.f / (float)((t + 1 < w) ? (t + 1) : w); const f32x4 d = a * ic - u;
          u32x2 o; o.x = pk2(d[0], d[1]); o.y = pk2(d[2], d[3]); *((u32x2*)(DPOOL + (size_t)m * 256) + lane) = o; }
        { const float ss = wave_sum((cq[0] * cq[0] + cq[1] * cq[1]) + (cq[2] * cq[2] + cq[3] * cq[3])); const float r = 1.f / sqrtf(ss * (1.f / 256.f) + 1e-6f);
          u32x2 o; o.x = pk2(cq[0] * r, cq[1] * r); o.y = pk2(cq[2] * r, cq[3] * r); *((u32x2*)(CQN + (size_t)m * 256) + lane) = o; }
        { const float sq = (lane < 32) ? (c2[0] * c2[0] + c2[1] * c2[1]) + (c2[2] * c2[2] + c2[3] * c2[3]) : 0.f;
          const float ss = wave_sum(sq); const float r = 1.f / sqrtf(ss * (1.f / 128.f) + 1e-6f);
          if (lane < 32) { u32x2 o; o.x = pk2(c2[0] * r, c2[1] * r); o.y = pk2(c2[2] * r, c2[3] * r); *((u32x2*)(CKVN + (size_t)m * 128) + lane) = o; }
          else if (lane < 48) { const int i0 = 2 * (lane - 32); const f32x4 cs = *(const f32x4*)(CS + ((size_t)m * 32 + i0) * 2);
            u32x2 o; o.x = pk2(c2[0] * cs[0] - c2[1] * cs[1], c2[1] * cs[0] + c2[0] * cs[1]); o.y = pk2(c2[2] * cs[2] - c2[3] * cs[3], c2[3] * cs[2] + c2[2] * cs[3]);
            *((u32x2*)(KROT + (size_t)m * 64) + (lane - 32)) = o; } }
    }
}

__device__ __forceinline__ int swap23(int r) { return (r & ~12) | ((r & 4) << 1) | ((r & 8) >> 1); }
template <int DQ>
__device__ __forceinline__ void attn_unit(LAS unsigned char* lds, const float* CSq, const bf16_t* Qw, int qpitch, const bf16_t* K1, int k1p, const bf16_t* K2, int k2p,
                                          const bf16_t* VT, int vtp, bf16_t* Ow, int opitch, int NT, int NTw) {
    constexpr int CH = DQ / 8, KP = DQ * 2 + 16, KB = 64 * KP, VP = 144, VB = 128 * VP, BUF = KB + VB, NKL = CH * 64 / NTHREADS, NKS = DQ / 16;
    static_assert(2 * BUF <= RING_BYTES && CH * 64 % NTHREADS == 0, "attention LDS");
    int tid = threadIdx.x; asm volatile("" : "+v"(tid));
    const int lane = tid & 63, r = lane & 31, h = lane >> 5;
    const bf16_t* kp[NKL]; int kst[NKL], kdst[NKL];
#pragma unroll
    for (int i = 0; i < NKL; ++i) { const int e = tid + NTHREADS * i, row = e / CH, c = e % CH;
        if (c < 16) { kp[i] = K1 + (size_t)row * k1p + c * 8; kst[i] = 64 * k1p; } else { kp[i] = K2 + (size_t)row * k2p + (c - 16) * 8; kst[i] = 64 * k2p; }
        kdst[i] = row * KP + c * 16; }
    const bf16_t* vp[2]; int vdst[2];
#pragma unroll
    for (int i = 0; i < 2; ++i) { const int e = tid + NTHREADS * i, row = e >> 3, c = e & 7; vp[i] = VT + (size_t)row * vtp + c * 8; vdst[i] = KB + row * VP + c * 16; }
    u32x4 kreg[NKL], vreg[2];
#define ATT_LOAD() do { _Pragma("unroll") for (int i = 0; i < NKL; ++i) { kreg[i] = *(const u32x4*)kp[i]; kp[i] += kst[i]; } \
                        _Pragma("unroll") for (int i = 0; i < 2; ++i) { vreg[i] = *(const u32x4*)vp[i]; vp[i] += 64; } } while (0)
#define ATT_STORE(buf) do { LAS unsigned char* b_ = lds + (buf) * BUF; _Pragma("unroll") for (int i = 0; i < NKL; ++i) *(LAS u32x4*)(b_ + kdst[i]) = kreg[i]; \
                        _Pragma("unroll") for (int i = 0; i < 2; ++i) *(LAS u32x4*)(b_ + vdst[i]) = vreg[i]; } while (0)
    ATT_LOAD();
    constexpr bool QREG = (DQ == 192);
    const bf16_t* qrow = Qw + (size_t)r * qpitch + h * 8;
    bf16x8 qf[QREG ? NKS : 1];
    if (QREG) {
#pragma unroll
        for (int ks = 0; ks < NKS; ++ks) qf[ks] = *(const bf16x8*)(qrow + ks * 16);
    }
    if (DQ == 192) {
#pragma unroll
        for (int ks = 8; ks < NKS; ++ks) { const float* cp = CSq + (size_t)r * 64 + ((ks - 8) * 8 + 4 * h) * 2; const f32x4 c0 = *(const f32x4*)cp, c1 = *(const f32x4*)(cp + 4);
            const float cc[4] = {c0[0], c0[2], c1[0], c1[2]}, sn[4] = {c0[1], c0[3], c1[1], c1[3]}; u32x4 w;
#pragma unroll
            for (int p = 0; p < 4; ++p) { const float x1 = __uint_as_float(((unsigned)(unsigned short)qf[ks][2 * p]) << 16), x2 = __uint_as_float(((unsigned)(unsigned short)qf[ks][2 * p + 1]) << 16);
                w[p] = pg8::cvt_pk_bf16(x1 * cc[p] - x2 * sn[p], x2 * cc[p] + x1 * sn[p]); }
            qf[ks] = __builtin_bit_cast(bf16x8, w); }
    }
    f32x16 o[4];
#pragma unroll
    for (int d = 0; d < 4; ++d)
#pragma unroll
        for (int i = 0; i < 16; ++i) o[d][i] = 0.f;
    float mrun = -1e30f, lrun = 0.f;
    ATT_STORE(0);
    __syncthreads();
    const int koff0 = swap23(r) * KP + h * 16, voff0 = KB + r * VP + h * 16;
    for (int t = 0; t < NT; ++t) {
        if (t + 1 < NT) ATT_LOAD();
        if (t < NTw) {
            const LAS unsigned char* kb = lds + (t & 1) * BUF;
            f32x16 s0, s1;
#pragma unroll
            for (int i = 0; i < 16; ++i) { s0[i] = 0.f; s1[i] = 0.f; }
#pragma unroll
            for (int ks = 0; ks < NKS; ++ks) {
                const bf16x8 a0 = *(const LAS bf16x8*)(kb + koff0 + ks * 32), a1 = *(const LAS bf16x8*)(kb + koff0 + 32 * KP + ks * 32);
                const bf16x8 qv = QREG ? qf[QREG ? ks : 0] : *(const bf16x8*)(qrow + ks * 16);
                s0 = __builtin_amdgcn_mfma_f32_32x32x16_bf16(a0, qv, s0, 0, 0, 0);
                s1 = __builtin_amdgcn_mfma_f32_32x32x16_bf16(a1, qv, s1, 0, 0, 0);
                if ((ks & 3) == 3) asm volatile("" ::: "memory");
            }
            float mx = fmaxf(s0[0], s1[0]);
#pragma unroll
            for (int i = 1; i < 16; ++i) mx = fmaxf(mx, fmaxf(s0[i], s1[i]));
            mx = fmaxf(mx, __shfl_xor(mx, 32));
            const float mnew = fmaxf(mrun, mx), alpha = __builtin_amdgcn_exp2f(mrun - mnew);
            mrun = mnew;
            float ls = 0.f;
#pragma unroll
            for (int i = 0; i < 16; ++i) { s0[i] = __builtin_amdgcn_exp2f(s0[i] - mnew); s1[i] = __builtin_amdgcn_exp2f(s1[i] - mnew); ls += s0[i] + s1[i]; }
            lrun = lrun * alpha + ls;
            if (__any(alpha != 1.0f)) {
#pragma unroll
                for (int d = 0; d < 4; ++d) o[d] = o[d] * alpha;
            }
            u32x4 pw[4];
#pragma unroll
            for (int s = 0; s < 2; ++s) {
                pw[s] = (u32x4){pg8::cvt_pk_bf16(s0[8 * s], s0[8 * s + 1]), pg8::cvt_pk_bf16(s0[8 * s + 2], s0[8 * s + 3]), pg8::cvt_pk_bf16(s0[8 * s + 4], s0[8 * s + 5]), pg8::cvt_pk_bf16(s0[8 * s + 6], s0[8 * s + 7])};
                pw[2 + s] = (u32x4){pg8::cvt_pk_bf16(s1[8 * s], s1[8 * s + 1]), pg8::cvt_pk_bf16(s1[8 * s + 2], s1[8 * s + 3]), pg8::cvt_pk_bf16(s1[8 * s + 4], s1[8 * s + 5]), pg8::cvt_pk_bf16(s1[8 * s + 6], s1[8 * s + 7])};
            }
#pragma unroll
            for (int kk = 0; kk < 4; ++kk) { const bf16x8 pb = __builtin_bit_cast(bf16x8, pw[kk]);
#pragma unroll
                for (int d = 0; d < 4; ++d) { const bf16x8 va = *(const LAS bf16x8*)(kb + voff0 + d * 32 * VP + kk * 32);
                    o[d] = __builtin_amdgcn_mfma_f32_32x32x16_bf16(va, pb, o[d], 0, 0, 0); }
                asm volatile("" ::: "memory"); }
        }
        if (t + 1 < NT) ATT_STORE((t + 1) & 1);
        __syncthreads();
    }
#undef ATT_LOAD
#undef ATT_STORE
    const float l = lrun + __shfl_xor(lrun, 32), il = 1.0f / l;
    bf16_t* orow = Ow + (size_t)r * opitch + 4 * h;
#pragma unroll
    for (int d = 0; d < 4; ++d)
#pragma unroll
        for (int g = 0; g < 4; ++g) { u32x2 w; w.x = pg8::cvt_pk_bf16(o[d][4 * g] * il, o[d][4 * g + 1] * il); w.y = pg8::cvt_pk_bf16(o[d][4 * g + 2] * il, o[d][4 * g + 3] * il);
            *(u32x2*)(orow + 32 * d + 8 * g) = w; }
}

#ifndef USE_XCD_BAR
#define USE_XCD_BAR 0
#endif
#define XB_TMO      128
#define XB_XCNT(j)  (256  + 64 * (j))
#define XB_XSUB(j)  (1280 + 64 * (j))
#define XB_XGEN(j)  (2304 + 64 * (j))
#define XB_TOP      3328
#define XB_TOPGEN   3392
#define XCD_BAR_WORDS 3456
#define XB_SPIN_CAP (1u << 18)

__device__ __forceinline__ unsigned xb_ld(unsigned* p)              { return __hip_atomic_load(p, __ATOMIC_RELAXED, __HIP_MEMORY_SCOPE_AGENT); }
__device__ __forceinline__ unsigned xb_add(unsigned* p, unsigned v) { return __hip_atomic_fetch_add(p, v, __ATOMIC_RELAXED, __HIP_MEMORY_SCOPE_AGENT); }
__device__ __forceinline__ unsigned xb_xcc_id() { return (unsigned)__builtin_amdgcn_s_getreg((3 << 11) | 20) & 0xFu; }
#define XB_SPIN(cond, bar) do { unsigned _sp = 0; while (cond) { __builtin_amdgcn_s_sleep(1); \
    if ((++_sp & 255u) == 0u) { if (xb_ld(&(bar)[XB_TMO])) break; if (_sp > XB_SPIN_CAP) { atomicAdd(&(bar)[XB_TMO], 1u); break; } } } } while (0)

struct XcdBarrier {
    unsigned* bar; unsigned x;
    volatile LAS unsigned* st;
};

__device__ __forceinline__ XcdBarrier xcd_barrier_post(unsigned* bar, volatile LAS unsigned* st) {
    XcdBarrier b; b.bar = bar; b.x = xb_xcc_id(); b.st = st;
    if (threadIdx.x == 0) (void)xb_add(&bar[XB_XCNT(b.x)], 1u);
    return b;
}
__device__ __forceinline__ void xcd_barrier_complete(unsigned* bar, unsigned x, unsigned& nloc, unsigned& nx) {
    const unsigned G = gridDim.x * gridDim.y * gridDim.z;
    unsigned sum, cnt, mine, sp = 0u;
    for (;;) {
        sum = 0u; cnt = 0u; mine = 0u;
#pragma unroll
        for (unsigned j = 0; j < 16; ++j) { const unsigned c = xb_ld(&bar[XB_XCNT(j)]); sum += c; cnt += (c > 0u) ? 1u : 0u; mine = (j == x) ? c : mine; }
        if (sum == G) break;
        __builtin_amdgcn_s_sleep(1);
        if ((++sp & 255u) == 0u) { if (xb_ld(&bar[XB_TMO])) break; if (sp > XB_SPIN_CAP) { atomicAdd(&bar[XB_TMO], 1u); break; } }
    }
    nloc = mine > 0u ? mine : 1u; nx = cnt > 0u ? cnt : 1u;
}

__device__ __forceinline__ void xcd_barrier(const XcdBarrier& b) {
    asm volatile("s_waitcnt vmcnt(0)" ::: "memory");
    __syncthreads();
    if (threadIdx.x == 0) {
        unsigned* bar = b.bar;
        __builtin_amdgcn_s_waitcnt(0);
        unsigned nloc = b.st[0], nx = b.st[1];
        if (nloc == 0u) { xcd_barrier_complete(bar, b.x, nloc, nx); b.st[0] = nloc; b.st[1] = nx; }
        const unsigned old = xb_add(&bar[XB_XSUB(b.x)], 1u);
        const unsigned gen = old / nloc;
        if (old + 1u == (gen + 1u) * nloc) {
            __builtin_amdgcn_fence(__ATOMIC_RELEASE, "agent");
            asm volatile("s_waitcnt vmcnt(0)" ::: "memory");
            const unsigned og = xb_add(&bar[XB_TOP], 1u);
            const unsigned tg = og / nx;
            if (og + 1u == (tg + 1u) * nx) xb_add(&bar[XB_TOPGEN], 1u);
            else XB_SPIN(xb_ld(&bar[XB_TOPGEN]) == tg, bar);
            __builtin_amdgcn_fence(__ATOMIC_ACQUIRE, "agent");
            xb_add(&bar[XB_XGEN(b.x)], 1u);
            asm volatile("s_waitcnt vmcnt(0)" ::: "memory");
        } else {
            XB_SPIN(xb_ld(&bar[XB_XGEN(b.x)]) == gen, bar);
            __builtin_amdgcn_fence(__ATOMIC_ACQUIRE, "agent");
            asm volatile("s_waitcnt vmcnt(0)" ::: "memory");
        }
    }
    __syncthreads();
}

enum { K_UP = 0, K_RES, K_LN, K_IN, K_MID, K_QKV, K_ATTN, K_CQ, K_CATTN, K_EONLY };

__global__ void __launch_bounds__(NTHREADS, 2) fwd_kernel(Params P) {
    extern __shared__ __attribute__((aligned(16))) unsigned char lds_raw[];
    LAS unsigned char* lds = (LAS unsigned char*)lds_raw;
    cg::grid_group grid = cg::this_grid();
    const int tid0 = threadIdx.x;
    for (int u = tid0; u < (LDS_BYTES - RING_BYTES) / 4; u += NTHREADS) ((LAS unsigned*)(lds + RING_BYTES))[u] = 0u;
    __syncthreads();
    volatile LAS unsigned* MISC = (volatile LAS unsigned*)(lds + MISC_OFF);
#if USE_XCD_BAR
    (void)xcd_barrier_post((unsigned*)(P.ws + WS_CTL) + CW_BAR, MISC + 8);
#define GSYNC() do { const __attribute__((address_space(4))) Params* pq = (const __attribute__((address_space(4))) Params*)__builtin_amdgcn_kernarg_segment_ptr(); asm volatile("" : "+s"(pq)); \
        XcdBarrier bar; bar.bar = (unsigned*)(pq->ws + WS_CTL) + CW_BAR; bar.x = xb_xcc_id(); bar.st = MISC + 8; xcd_barrier(bar); } while (0)
#else
#define GSYNC() grid.sync()
#endif
#define WSP(T, off) ((T*)(ws + (off)))
#define XN WSP(bf16_t, WS_XN)
#define Y WSP(float, WS_Y)
#define H WSP(bf16_t, WS_H)
#define HIN WSP(float, WS_HIN)
#define Qb WSP(bf16_t, WS_Q)
#define KN WSP(bf16_t, WS_KN)
#define VT WSP(bf16_t, WS_VT)
#define CQN WSP(bf16_t, WS_CQN)
#define CKVN WSP(bf16_t, WS_CKVN)
#define KROT WSP(bf16_t, WS_KROT)
#define DPOOL WSP(bf16_t, WS_DPOOL)
#define YCAT WSP(bf16_t, WS_YCAT)
#define QC WSP(bf16_t, WS_QC)
#define OC WSP(bf16_t, WS_OC)
#define MEMB WSP(bf16_t, WS_MEMB)
#define CS WSP(const float, WS_CS)
    { const int wave = __builtin_amdgcn_readfirstlane(tid0 >> 6); prologue(P, lds, blockIdx.x * NWAVES + wave, gridDim.x * NWAVES, wave, tid0 & 63); }
    grid.sync();

#define PHASE_BEGIN { constexpr int l = LCONST; (void)l; int tid = threadIdx.x; asm volatile("" : "+v"(tid)); const int lane = tid & 63, wave = __builtin_amdgcn_readfirstlane(tid >> 6); (void)lane; (void)wave; const int G = gridDim.x, gw = blockIdx.x * NWAVES + wave, NGW = G * NWAVES; (void)gw; (void)NGW; \
        const __attribute__((address_space(4))) Params* pp = (const __attribute__((address_space(4))) Params*)__builtin_amdgcn_kernarg_segment_ptr(); asm volatile("" : "+s"(pp)); \
        unsigned char* ws = pp->ws; unsigned char* wl = ws + WS_W + (size_t)l * LW; (void)wl;
#define PHASE_END_SYNC } GSYNC();
#define PHASE_END_NOSYNC } __syncthreads();
#define RUN_GEMM(EPI, M_, N_, K_, Aptr, Bptr, ...) do { pg8::Gemm g{(const bf16_t*)(Aptr), (const bf16_t*)(Bptr), M_, N_, K_}; pg8::StaticOrder S; S.init(M_, N_, G, (int)blockIdx.x); \
            pg8::EPI E{__VA_ARGS__}; pg8::gemm_phase<pg8::EPI, pg8::StaticOrder, true, true>(lds, g, S, E); } while (0)
#define RUN_GEMM_RK(EPI, M_, N_, K_, Aptr, Bptr, ...) do { int Kr = K_; asm volatile("" : "+s"(Kr)); pg8::Gemm g{(const bf16_t*)(Aptr), (const bf16_t*)(Bptr), M_, N_, Kr}; pg8::StaticOrder S; S.init(M_, N_, G, (int)blockIdx.x); \
            pg8::EPI E{__VA_ARGS__}; pg8::gemm_phase<pg8::EPI, pg8::StaticOrder, true, false>(lds, g, S, E); } while (0)
#define LN_PHASE_LAST(i) PHASE_BEGIN ln_pass(Y, pp->ln_g + (size_t)(l * 4 + (i)) * DM, pp->ln_b + (size_t)(l * 4 + (i)) * DM, pp->out, XN, gw, NGW, lane); }
#define LN_PHASE(i) PHASE_BEGIN ln_pass(Y, pp->ln_g + (size_t)(l * 4 + (i)) * DM, pp->ln_b + (size_t)(l * 4 + (i)) * DM, pp->out, XN, gw, NGW, lane); PHASE_END_SYNC

#define LCONST 0
    PHASE_BEGIN RUN_GEMM(EpiBf16, NB * NMEM, DM, DM, MEMB, ws + WS_W + OW_MK, (bf16_t*)(ws + WS_MEMK), DM); PHASE_END_NOSYNC
    PHASE_BEGIN RUN_GEMM(EpiBf16, DM, NB * NMEM, DM, ws + WS_W + OW_MV, MEMB, (bf16_t*)(ws + WS_MEMVT), NB * NMEM); PHASE_END_NOSYNC
    PHASE_BEGIN RUN_GEMM(EpiBf16, NB * NMEM, DM, DM, MEMB, ws + WS_W + LW + OW_MK, (bf16_t*)(ws + WS_MEMK + 4 * MiB), DM); PHASE_END_NOSYNC
    PHASE_BEGIN RUN_GEMM(EpiBf16, DM, NB * NMEM, DM, ws + WS_W + LW + OW_MV, MEMB, (bf16_t*)(ws + WS_MEMVT + 4 * MiB), NB * NMEM); PHASE_END_NOSYNC

        PHASE_BEGIN RUN_GEMM(EpiSwiGLU, MTOK, 2 * DFF, DM, XN, wl + OW_13A, H, DFF); PHASE_END_SYNC
        PHASE_BEGIN RUN_GEMM(EpiRes, MTOK, DM, DFF, H, wl + OW_2A, (l == 0) ? pp->x : pp->out, Y, DM, ALPHA_F, 0.5f); PHASE_END_SYNC
        LN_PHASE(0)
        PHASE_BEGIN RUN_GEMM(EpiF32, MTOK, HINW, DM, XN, wl + OW_IN, HIN, HINW); PHASE_END_SYNC
        PHASE_BEGIN mid_pass(HIN, CS, DPOOL, CQN, CKVN, KROT, gw, NGW, lane); PHASE_END_SYNC
        PHASE_BEGIN RUN_GEMM_RK(EpiBf16, MTOK, QP, 256, CQN, wl + OW_UQ, Qb, QP); PHASE_END_NOSYNC
        PHASE_BEGIN RUN_GEMM_RK(EpiBf16, MTOK, KNW, 128, CKVN, wl + OW_K, KN, KNW); PHASE_END_NOSYNC
        PHASE_BEGIN RUN_GEMM_RK(EpiBf16, KNW, MTOK, 128, wl + OW_V, CKVN, VT, MTOK); PHASE_END_NOSYNC
        PHASE_BEGIN RUN_GEMM_RK(EpiBf16, MTOK, 256, 256, DPOOL, wl + OW_POOL, YCAT, DM); PHASE_END_SYNC
        PHASE_BEGIN
            unsigned* qctr = (unsigned*)(ws + WS_CTL) + CW_QUEUE + 64 * l;
            for (;;) {
                if (tid == 0) MISC[0] = atomicAdd(qctr, 1u);
                __syncthreads();
                const int u = __builtin_amdgcn_readfirstlane((int)MISC[0]);
                __syncthreads();
                if (u >= NB * NHEAD * 16) break;
                const int qb = 15 - u / 48, bh = u % 48, b = bh / 6, hd = bh % 6;
                const size_t tok0 = (size_t)b * SEQ, tq = tok0 + qb * 256 + wave * 32;
                attn_unit<192>(lds, CS + tq * 64, Qb + tq * QP + hd * DQK, QP, KN + tok0 * KNW + hd * 128, KNW, KROT + tok0 * 64, 64, VT + (size_t)(hd * 128) * MTOK + tok0, MTOK,
                               YCAT + tq * DM + 256 + hd * 128, DM, 4 * qb + 4, 4 * qb + (wave >> 1) + 1);
            }
        PHASE_END_SYNC
        PHASE_BEGIN RUN_GEMM(EpiRes, MTOK, DM, DM, YCAT, wl + OW_OUT, pp->out, Y, DM, ALPHA_F, 1.0f); PHASE_END_SYNC
        LN_PHASE(1)
        PHASE_BEGIN RUN_GEMM(EpiBf16, MTOK, DM, DM, XN, wl + OW_MQ, QC, DM); PHASE_END_SYNC
        PHASE_BEGIN
            const bf16_t* MEMK = (const bf16_t*)(ws + WS_MEMK + (size_t)l * 4 * MiB); const bf16_t* MEMVT = (const bf16_t*)(ws + WS_MEMVT + (size_t)l * 4 * MiB);
            for (int u = blockIdx.x; u < NB * 4 * 16 * 2; u += G) {
                const int half = u & 1, qb = (u >> 1) & 15, bh = u >> 5, b = bh >> 2, hd = bh & 3;
                const size_t tq = (size_t)b * SEQ + qb * 256 + wave * 32;
                const bf16_t* k1 = MEMK + (size_t)(b * NMEM) * DM + hd * 256;
                attn_unit<256>(lds, nullptr, QC + tq * DM + hd * 256, DM, k1, DM, k1 + 128, DM, MEMVT + (size_t)(hd * 256 + half * 128) * (NB * NMEM) + b * NMEM, NB * NMEM,
                               OC + tq * DM + hd * 256 + half * 128, DM, 4, 4);
            }
        PHASE_END_SYNC
        PHASE_BEGIN RUN_GEMM(EpiRes, MTOK, DM, DM, OC, wl + OW_MO, pp->out, Y, DM, ALPHA_F, 1.0f); PHASE_END_SYNC
        LN_PHASE(2)
        PHASE_BEGIN RUN_GEMM(EpiSwiGLU, MTOK, 2 * DFF, DM, XN, wl + OW_13B, H, DFF); PHASE_END_SYNC
        PHASE_BEGIN RUN_GEMM(EpiRes, MTOK, DM, DFF, H, wl + OW_2B, pp->out, Y, DM, ALPHA_F, 0.5f); PHASE_END_SYNC
        LN_PHASE(3)
#undef LCONST
#define LCONST 1
        PHASE_BEGIN RUN_GEMM(EpiSwiGLU, MTOK, 2 * DFF, DM, XN, wl + OW_13A, H, DFF); PHASE_END_SYNC
        PHASE_BEGIN RUN_GEMM(EpiRes, MTOK, DM, DFF, H, wl + OW_2A, (l == 0) ? pp->x : pp->out, Y, DM, ALPHA_F, 0.5f); PHASE_END_SYNC
        LN_PHASE(0)
        PHASE_BEGIN RUN_GEMM(EpiF32, MTOK, HINW, DM, XN, wl + OW_IN, HIN, HINW); PHASE_END_SYNC
        PHASE_BEGIN mid_pass(HIN, CS, DPOOL, CQN, CKVN, KROT, gw, NGW, lane); PHASE_END_SYNC
        PHASE_BEGIN RUN_GEMM_RK(EpiBf16, MTOK, QP, 256, CQN, wl + OW_UQ, Qb, QP); PHASE_END_NOSYNC
        PHASE_BEGIN RUN_GEMM_RK(EpiBf16, MTOK, KNW, 128, CKVN, wl + OW_K, KN, KNW); PHASE_END_NOSYNC
        PHASE_BEGIN RUN_GEMM_RK(EpiBf16, KNW, MTOK, 128, wl + OW_V, CKVN, VT, MTOK); PHASE_END_NOSYNC
        PHASE_BEGIN RUN_GEMM_RK(EpiBf16, MTOK, 256, 256, DPOOL, wl + OW_POOL, YCAT, DM); PHASE_END_SYNC
        PHASE_BEGIN
            unsigned* qctr = (unsigned*)(ws + WS_CTL) + CW_QUEUE + 64 * l;
            for (;;) {
                if (tid == 0) MISC[0] = atomicAdd(qctr, 1u);
                __syncthreads();
                const int u = __builtin_amdgcn_readfirstlane((int)MISC[0]);
                __syncthreads();
                if (u >= NB * NHEAD * 16) break;
                const int qb = 15 - u / 48, bh = u % 48, b = bh / 6, hd = bh % 6;
                const size_t tok0 = (size_t)b * SEQ, tq = tok0 + qb * 256 + wave * 32;
                attn_unit<192>(lds, CS + tq * 64, Qb + tq * QP + hd * DQK, QP, KN + tok0 * KNW + hd * 128, KNW, KROT + tok0 * 64, 64, VT + (size_t)(hd * 128) * MTOK + tok0, MTOK,
                               YCAT + tq * DM + 256 + hd * 128, DM, 4 * qb + 4, 4 * qb + (wave >> 1) + 1);
            }
        PHASE_END_SYNC
        PHASE_BEGIN RUN_GEMM(EpiRes, MTOK, DM, DM, YCAT, wl + OW_OUT, pp->out, Y, DM, ALPHA_F, 1.0f); PHASE_END_SYNC
        LN_PHASE(1)
        PHASE_BEGIN RUN_GEMM(EpiBf16, MTOK, DM, DM, XN, wl + OW_MQ, QC, DM); PHASE_END_SYNC
        PHASE_BEGIN
            const bf16_t* MEMK = (const bf16_t*)(ws + WS_MEMK + (size_t)l * 4 * MiB); const bf16_t* MEMVT = (const bf16_t*)(ws + WS_MEMVT + (size_t)l * 4 * MiB);
            for (int u = blockIdx.x; u < NB * 4 * 16 * 2; u += G) {
                const int half = u & 1, qb = (u >> 1) & 15, bh = u >> 5, b = bh >> 2, hd = bh & 3;
                const size_t tq = (size_t)b * SEQ + qb * 256 + wave * 32;
                const bf16_t* k1 = MEMK + (size_t)(b * NMEM) * DM + hd * 256;
                attn_unit<256>(lds, nullptr, QC + tq * DM + hd * 256, DM, k1, DM, k1 + 128, DM, MEMVT + (size_t)(hd * 256 + half * 128) * (NB * NMEM) + b * NMEM, NB * NMEM,
                               OC + tq * DM + hd * 256 + half * 128, DM, 4, 4);
            }
        PHASE_END_SYNC
        PHASE_BEGIN RUN_GEMM(EpiRes, MTOK, DM, DM, OC, wl + OW_MO, pp->out, Y, DM, ALPHA_F, 1.0f); PHASE_END_SYNC
        LN_PHASE(2)
        PHASE_BEGIN RUN_GEMM(EpiSwiGLU, MTOK, 2 * DFF, DM, XN, wl + OW_13B, H, DFF); PHASE_END_SYNC
        PHASE_BEGIN RUN_GEMM(EpiRes, MTOK, DM, DFF, H, wl + OW_2B, pp->out, Y, DM, ALPHA_F, 0.5f); PHASE_END_SYNC
        LN_PHASE_LAST(3)
#undef LCONST
}

extern "C" void kernel_launch(void* const* d_in, const int* in_sizes, int n_in, void* d_out, int out_size, void* d_ws, size_t ws_size, hipStream_t stream) {
    static int grid = 0;
    if (grid == 0) {
        if (n_in != 20 || in_sizes[0] != MTOK * DM || out_size != MTOK * DM || ws_size < WS_END) {
            fprintf(stderr, "kernel_launch: unexpected shapes (n_in %d, in0 %d, out %d, ws %zu < %zu)\n", n_in, n_in > 0 ? in_sizes[0] : -1, out_size, ws_size, (size_t)WS_END); grid = -1; return; }
        int dev = 0, cus = 0, per_cu = 0;
        hipGetDevice(&dev); hipDeviceGetAttribute(&cus, hipDeviceAttributeMultiprocessorCount, dev);
        if (hipFuncSetAttribute((const void*)fwd_kernel, hipFuncAttributeMaxDynamicSharedMemorySize, LDS_BYTES) != hipSuccess) { fprintf(stderr, "kernel_launch: hipFuncSetAttribute failed\n"); grid = -1; return; }
        if (hipOccupancyMaxActiveBlocksPerMultiprocessor(&per_cu, (const void*)fwd_kernel, NTHREADS, LDS_BYTES) != hipSuccess || per_cu < 1) per_cu = 1;
        (void)hipGetLastError();
        if (per_cu > 1) per_cu = 1;
        grid = cus * per_cu;
    }
    if (grid < 0) return;
    hipMemsetAsync((char*)d_ws + WS_CTL, 0, CTL_ZERO_BYTES, stream);
    Params p{};
    p.x = (const float*)d_in[0]; p.mem = (const float*)d_in[1]; p.pos = (const int*)d_in[2]; p.ln_g = (const float*)d_in[3]; p.ln_b = (const float*)d_in[4];
    p.ffn1_w13 = (const float*)d_in[5]; p.ffn1_w2 = (const float*)d_in[6]; p.w_in = (const float*)d_in[7]; p.pool_w = (const float*)d_in[8]; p.pool_scale = (const float*)d_in[9];
    p.q_norm_g = (const float*)d_in[10]; p.w_uq = (const float*)d_in[11]; p.kv_norm_g = (const float*)d_in[12]; p.w_ukv = (const float*)d_in[13]; p.w_out = (const float*)d_in[14];
    p.mem_wq = (const float*)d_in[15]; p.mem_wkv = (const float*)d_in[16]; p.mem_wo = (const float*)d_in[17]; p.ffn2_w13 = (const float*)d_in[18]; p.ffn2_w2 = (const float*)d_in[19];
    p.out = (float*)d_out; p.ws = (unsigned char*)d_ws;
    void* args[] = {&p};
    hipError_t e = hipLaunchCooperativeKernel((const void*)fwd_kernel, dim3(grid), dim3(NTHREADS), args, LDS_BYTES, stream);
    if (e != hipSuccess) fprintf(stderr, "kernel_launch: cooperative launch failed: %s (grid %d)\n", hipGetErrorString(e), grid);
}
```

```cpp
#include <hip/hip_runtime.h>
#include <hip/hip_cooperative_groups.h>
#include <cstdio>
#include <cstdint>
#include <cmath>
namespace cg = cooperative_groups;
namespace pg8 {
#define PG8_LAS __attribute__((address_space(3)))
typedef unsigned short bf16_t;
typedef short bf16x8 __attribute__((ext_vector_type(8)));
typedef float f32x4 __attribute__((ext_vector_type(4)));
typedef unsigned u32x4 __attribute__((ext_vector_type(4)));
constexpr int BM = 256, BK = 64, HALF = 128, HTB = HALF * BK * 2  , STAGE_BYTES = 8 * HTB, NXCD = 8, WGM = 8;

__host__ __device__ __forceinline__ int lds_byte(int r, int c) { const int st = (r >> 4) * 2 + (c >> 5), rr = r & 15, cc = c & 31, ob = rr * 64 + cc * 2; return st * 1024 + (ob ^ (((ob >> 9) & 1) << 5)); }
__host__ __device__ __forceinline__ void stage_rc(int b, int& R, int& C) { const int st = b / 1024, sb = b % 1024, swz = sb ^ (((sb >> 9) & 1) << 5); R = (st >> 1) * 16 + swz / 64; C = (st & 1) * 32 + (swz % 64) / 2; }
__host__ __device__ __forceinline__ int perm32(int rho) { const int n = rho >> 4, i = rho & 15; return 8 * (i >> 2) + 4 * n + (i & 3); }

struct Unit { int pm, pn; };
struct Gemm { const bf16_t* A; const bf16_t* Bt; int M, N, K; };

struct StaticOrder {
    int nM, nN, nwg, G, c;
    __host__ __device__ void init(int M, int N, int G_, int c_) { nM = M / BM; nN = N / BM; nwg = nM * nN; G = G_; c = c_; }
    __host__ __device__ bool next(int i, Unit& u) const {
        const long L = (long)i * G + c; if (L >= nwg) return false;
        int wgid = (int)L; { const int q = nwg / NXCD, r = nwg % NXCD, xcd = wgid % NXCD, off = wgid / NXCD; wgid = (xcd < r ? xcd * (q + 1) : r * (q + 1) + (xcd - r) * q) + off; }
        const int nig = WGM * nN, gid = wgid / nig, fm = gid * WGM, gsz = (nM - fm) < WGM ? (nM - fm) : WGM;
        u.pm = fm + ((wgid % nig) % gsz); u.pn = (wgid % nig) / gsz; return true;
    }
    __device__ __forceinline__ void a_ready(const Unit&) const {}
    __device__ __forceinline__ void done(const Unit&) const {}
};

typedef float f32x2 __attribute__((ext_vector_type(2)));
typedef __bf16 bf16x2_t __attribute__((ext_vector_type(2)));
__device__ __forceinline__ unsigned cvt_pk_bf16(float lo, float hi) { f32x2 v = {lo, hi}; bf16x2_t b = __builtin_convertvector(v, bf16x2_t); return __builtin_bit_cast(unsigned, b); }

struct EpiBf16 {
    static constexpr bool PERM = true, AFTER_DRAIN = false;
    bf16_t* O; int ldc;
    __device__ __forceinline__ void operator()(const f32x4 (&acc)[2][2][4][2], const Unit& u, int wr, int wc, int fr, int fq) const {
        const int row0 = u.pm * BM + wr * 64 + fr, col0 = u.pn * BM + wc * 32 + 8 * fq;
#pragma unroll
        for (int ai = 0; ai < 2; ++ai)
#pragma unroll
            for (int m = 0; m < 4; ++m) { bf16_t* rowp = O + (size_t)(row0 + ai * HALF + m * 16) * ldc + col0;
#pragma unroll
                for (int bj = 0; bj < 2; ++bj) { const f32x4 v0 = acc[ai][bj][m][0], v1 = acc[ai][bj][m][1];
                    u32x4 w; w.x = cvt_pk_bf16(v0[0], v0[1]); w.y = cvt_pk_bf16(v0[2], v0[3]); w.z = cvt_pk_bf16(v1[0], v1[1]); w.w = cvt_pk_bf16(v1[2], v1[3]);
                    *(u32x4*)(rowp + bj * HALF) = w; } }
    }
};
struct EpiSwiGLU {
    static constexpr bool PERM = true, AFTER_DRAIN = false;
    bf16_t* O; int ldc;
    __device__ __forceinline__ void operator()(const f32x4 (&acc)[2][2][4][2], const Unit& u, int wr, int wc, int fr, int fq) const {
        const int row0 = u.pm * BM + wr * 64 + fr, col0 = u.pn * HALF + wc * 32 + 8 * fq;
#pragma unroll
        for (int ai = 0; ai < 2; ++ai)
#pragma unroll
            for (int m = 0; m < 4; ++m) { bf16_t* rowp = O + (size_t)(row0 + ai * HALF + m * 16) * ldc + col0;
                float h[8];
#pragma unroll
                for (int n = 0; n < 2; ++n)
#pragma unroll
                    for (int j = 0; j < 4; ++j) { const float g = acc[ai][0][m][n][j], up = acc[ai][1][m][n][j];
                        const float sg = __builtin_amdgcn_rcpf(1.0f + __builtin_amdgcn_exp2f(-1.4426950408889634f * g));
                        h[n * 4 + j] = g * sg * up; }
                u32x4 w; w.x = cvt_pk_bf16(h[0], h[1]); w.y = cvt_pk_bf16(h[2], h[3]); w.z = cvt_pk_bf16(h[4], h[5]); w.w = cvt_pk_bf16(h[6], h[7]);
                *(u32x4*)rowp = w; }
    }
};
struct EpiRes {
    static constexpr bool PERM = false, AFTER_DRAIN = false;
    const float* X; float* Y; int ldc; float alpha, s;
    __device__ __forceinline__ void operator()(const f32x4 (&acc)[2][2][4][2], const Unit& u, int wr, int wc, int fr, int fq) const {
        const int col0 = u.pn * BM + wc * 32 + 4 * fq;
#pragma unroll
        for (int ai = 0; ai < 2; ++ai)
#pragma unroll
            for (int m = 0; m < 4; ++m) { const size_t off = (size_t)(u.pm * BM + ai * HALF + wr * 64 + m * 16 + fr) * ldc + col0;
#pragma unroll
                for (int bj = 0; bj < 2; ++bj)
#pragma unroll
                    for (int n = 0; n < 2; ++n) { const f32x4 xv = *(const f32x4*)(X + off + bj * HALF + n * 16);
                        *(f32x4*)(Y + off + bj * HALF + n * 16) = xv * alpha + acc[ai][bj][m][n] * s; } }
    }
};
struct EpiF32 {
    static constexpr bool PERM = false, AFTER_DRAIN = false;
    float* O; int ldc;
    __device__ __forceinline__ void operator()(const f32x4 (&acc)[2][2][4][2], const Unit& u, int wr, int wc, int fr, int fq) const {
        const int col0 = u.pn * BM + wc * 32 + 4 * fq;
#pragma unroll
        for (int ai = 0; ai < 2; ++ai)
#pragma unroll
            for (int m = 0; m < 4; ++m) { const size_t off = (size_t)(u.pm * BM + ai * HALF + wr * 64 + m * 16 + fr) * ldc + col0;
#pragma unroll
                for (int bj = 0; bj < 2; ++bj)
#pragma unroll
                    for (int n = 0; n < 2; ++n) *(f32x4*)(O + off + bj * HALF + n * 16) = acc[ai][bj][m][n]; }
    }
};
template <class Epi, class Sched, bool ALIGN_EPI = false, bool SP2 = false>
__device__ __forceinline__ void gemm_phase(PG8_LAS unsigned char* lds, const Gemm g, const Sched& S, const Epi& E) {
    int tid = threadIdx.x; asm volatile("" : "+v"(tid));
    const int wid = __builtin_amdgcn_readfirstlane(tid >> 6), lane = tid & 63, wr = wid >> 2, wc = wid & 3, fr = lane & 15, fq = lane >> 4;
    const int K = g.K, nt = K / BK;
    unsigned voffA[2], voffB[2];
#pragma unroll
    for (int i = 0; i < 2; ++i) { int R, C; stage_rc(tid * 16 + i * 8192, R, C); const int Rb = Epi::PERM ? ((R & ~31) + perm32(R & 31)) : R;
        voffA[i] = (unsigned)(R * K + C) * 2u; voffB[i] = (unsigned)(Rb * K + C) * 2u; }
    const size_t kstep = (size_t)(BK * 2);
    const size_t hstep = (size_t)HALF * K * 2;
    const size_t tstep = 2 * hstep;
    const unsigned ldsw = (unsigned)wid * 1024u;
    const int aoff = lds_byte(wr * 64 + fr, fq * 8), boff = lds_byte(wc * 32 + fr, fq * 8);
#define PG8_SA(b, h) (((b) * 2 + (h)) * HTB)
#define PG8_SB(b, h) ((4 + (b) * 2 + (h)) * HTB)
#define PG8_STAGE(bufoff, gbase, voff) do { _Pragma("unroll") for (int _i = 0; _i < 2; ++_i) \
        __builtin_amdgcn_global_load_lds((const unsigned*)((const char*)(gbase) + (voff)[_i]), (PG8_LAS unsigned*)(lds + (bufoff) + ldsw + _i * 8192), 16, 0, 0); } while (0)
#define PG8_LDA(dst, b, h) do { _Pragma("unroll") for (int m = 0; m < 4; ++m) _Pragma("unroll") for (int k = 0; k < 2; ++k) dst[m][k] = *(const PG8_LAS bf16x8*)(lds + PG8_SA(b, h) + aoff + m * 2048 + k * 1024); } while (0)
#define PG8_LDB(dst, b, h) do { _Pragma("unroll") for (int n = 0; n < 2; ++n) _Pragma("unroll") for (int k = 0; k < 2; ++k) dst[n][k] = *(const PG8_LAS bf16x8*)(lds + PG8_SB(b, h) + boff + n * 2048 + k * 1024); } while (0)
#define PG8_MMA(ai, bj, At, Bt) do { __builtin_amdgcn_s_setprio(1); _Pragma("unroll") for (int m = 0; m < 4; ++m) _Pragma("unroll") for (int n = 0; n < 2; ++n) _Pragma("unroll") for (int k = 0; k < 2; ++k) \
        acc[ai][bj][m][n] = __builtin_amdgcn_mfma_f32_16x16x32_bf16(Bt[n][k], At[m][k], acc[ai][bj][m][n], 0, 0, 0); __builtin_amdgcn_s_setprio(0); } while (0)
#define PG8_WAIT_V(n) asm volatile("s_waitcnt vmcnt(" #n ")" ::: "memory")
#define PG8_WAIT_L(n) asm volatile("s_waitcnt lgkmcnt(" #n ")" ::: "memory")
#define PG8_BAR __builtin_amdgcn_s_barrier()
#define PG8_SCHED __builtin_amdgcn_sched_barrier(0)
    Unit cur, nxt; int ui = 0;
    if (!S.next(0, cur)) return;
    f32x4 acc[2][2][4][2];
#pragma unroll
    for (int a = 0; a < 2; ++a)
#pragma unroll
        for (int b = 0; b < 2; ++b)
#pragma unroll
            for (int m = 0; m < 4; ++m)
#pragma unroll
                for (int n = 0; n < 2; ++n) acc[a][b][m][n] = (f32x4){0.f, 0.f, 0.f, 0.f};
    bf16x8 At[4][2], B0[2][2], B1[2][2];
    const char* cA = (const char*)g.A + (size_t)cur.pm * tstep; const char* cB = (const char*)g.Bt + (size_t)cur.pn * tstep;
    S.a_ready(cur);
    if constexpr (SP2) {
        PG8_STAGE(PG8_SB(0, 0), cB, voffB); PG8_STAGE(PG8_SB(0, 1), cB + hstep, voffB); PG8_STAGE(PG8_SA(0, 0), cA, voffA); PG8_STAGE(PG8_SA(0, 1), cA + hstep, voffA);
        if (wr == 1) PG8_BAR;
        PG8_WAIT_V(2); PG8_BAR;
        PG8_STAGE(PG8_SB(1, 0), cB + kstep, voffB); PG8_STAGE(PG8_SA(1, 0), cA + kstep, voffA); PG8_STAGE(PG8_SB(1, 1), cB + hstep + kstep, voffB);
        PG8_WAIT_V(6); PG8_BAR;
    } else {
        PG8_STAGE(PG8_SB(0, 0), cB, voffB); PG8_STAGE(PG8_SA(0, 0), cA, voffA); PG8_STAGE(PG8_SB(0, 1), cB + hstep, voffB); PG8_STAGE(PG8_SA(0, 1), cA + hstep, voffA);
        if (wr == 1) PG8_BAR;
        PG8_WAIT_V(4); PG8_BAR;
        PG8_STAGE(PG8_SB(1, 0), cB + kstep, voffB); PG8_STAGE(PG8_SA(1, 0), cA + kstep, voffA); PG8_STAGE(PG8_SB(1, 1), cB + hstep + kstep, voffB);
        PG8_WAIT_V(6); PG8_BAR;
    }
    for (;;) {
        const bool has_next = S.next(ui + 1, nxt);
        const char* nA = has_next ? (const char*)g.A + (size_t)nxt.pm * tstep : cA; const char* nB = has_next ? (const char*)g.Bt + (size_t)nxt.pn * tstep : cB;
        for (int t = 0; t < nt; t += 2) {
            const bool last = (t == nt - 2);
            const char* a1 = cA + (size_t)(t + 1) * kstep;
            const char* a2 = last ? nA : cA + (size_t)(t + 2) * kstep; const char* b2 = last ? nB : cB + (size_t)(t + 2) * kstep;
            const char* a3 = a2 + kstep; const char* b3 = b2 + kstep;
            if (last && has_next) S.a_ready(nxt);
            if constexpr (SP2) {
            PG8_LDB(B0, 0, 0); PG8_LDB(B1, 0, 1); PG8_SCHED; PG8_LDA(At, 0, 0); PG8_STAGE(PG8_SA(1, 1), a1 + hstep, voffA);
            PG8_WAIT_V(8); PG8_WAIT_L(0); PG8_BAR; PG8_MMA(0, 0, At, B0); PG8_MMA(0, 1, At, B1); PG8_BAR; PG8_SCHED;
            PG8_LDA(At, 0, 1); PG8_STAGE(PG8_SB(0, 0), b2, voffB); PG8_STAGE(PG8_SB(0, 1), b2 + hstep, voffB); PG8_STAGE(PG8_SA(0, 0), a2, voffA);
            PG8_WAIT_V(8); PG8_WAIT_L(0); PG8_BAR; PG8_MMA(1, 0, At, B0); PG8_MMA(1, 1, At, B1); PG8_BAR; PG8_SCHED;
            PG8_LDB(B0, 1, 0); PG8_LDB(B1, 1, 1); PG8_SCHED; PG8_LDA(At, 1, 0); PG8_STAGE(PG8_SA(0, 1), a2 + hstep, voffA);
            PG8_WAIT_V(8); PG8_WAIT_L(0); PG8_BAR; PG8_MMA(0, 0, At, B0); PG8_MMA(0, 1, At, B1); PG8_BAR; PG8_SCHED;
            PG8_LDA(At, 1, 1); PG8_STAGE(PG8_SB(1, 0), b3, voffB); PG8_STAGE(PG8_SB(1, 1), b3 + hstep, voffB); PG8_STAGE(PG8_SA(1, 0), a3, voffA);
            PG8_WAIT_V(8); PG8_WAIT_L(0); PG8_BAR; PG8_MMA(1, 0, At, B0); PG8_MMA(1, 1, At, B1); PG8_BAR; PG8_SCHED;
            } else {
            PG8_LDB(B0, 0, 0); PG8_SCHED; PG8_LDA(At, 0, 0); PG8_STAGE(PG8_SA(1, 1), a1 + hstep, voffA);
            PG8_WAIT_L(8); PG8_BAR; PG8_WAIT_L(0); PG8_MMA(0, 0, At, B0); PG8_BAR; PG8_SCHED;
            PG8_LDB(B1, 0, 1); PG8_STAGE(PG8_SB(0, 0), b2, voffB);
            PG8_BAR; PG8_WAIT_L(0); PG8_MMA(0, 1, At, B1); PG8_BAR;
            PG8_LDA(At, 0, 1); PG8_STAGE(PG8_SA(0, 0), a2, voffA);
            PG8_BAR; PG8_WAIT_L(0); PG8_MMA(1, 0, At, B0); PG8_BAR; PG8_SCHED;
            PG8_STAGE(PG8_SB(0, 1), b2 + hstep, voffB);
            PG8_WAIT_V(6); PG8_BAR; PG8_MMA(1, 1, At, B1); PG8_BAR;
            PG8_LDB(B0, 1, 0); PG8_SCHED; PG8_LDA(At, 1, 0); PG8_STAGE(PG8_SA(0, 1), a2 + hstep, voffA);
            PG8_WAIT_L(8); PG8_BAR; PG8_WAIT_L(0); PG8_MMA(0, 0, At, B0); PG8_BAR; PG8_SCHED;
            PG8_LDB(B1, 1, 1); PG8_STAGE(PG8_SB(1, 0), b3, voffB);
            PG8_BAR; PG8_WAIT_L(0); PG8_MMA(0, 1, At, B1); PG8_BAR;
            PG8_LDA(At, 1, 1); PG8_STAGE(PG8_SA(1, 0), a3, voffA);
            PG8_BAR; PG8_WAIT_L(0); PG8_MMA(1, 0, At, B0); PG8_BAR; PG8_SCHED;
            PG8_STAGE(PG8_SB(1, 1), b3 + hstep, voffB);
            PG8_WAIT_V(6); PG8_BAR; PG8_MMA(1, 1, At, B1); PG8_BAR;
            }
        }
        if constexpr (ALIGN_EPI) { if (wr == 0) PG8_BAR; }
        if constexpr (!Epi::AFTER_DRAIN) { E(acc, cur, wr, wc, fr, fq); S.done(cur); }
        if (!has_next) break;
#pragma unroll
        for (int a = 0; a < 2; ++a)
#pragma unroll
            for (int b = 0; b < 2; ++b)
#pragma unroll
                for (int m = 0; m < 4; ++m)
#pragma unroll
                    for (int n = 0; n < 2; ++n) acc[a][b][m][n] = (f32x4){0.f, 0.f, 0.f, 0.f};
        cur = nxt; cA = nA; cB = nB; ++ui;
        if constexpr (ALIGN_EPI) { if (wr == 1) PG8_BAR; }
    }
    PG8_WAIT_V(0);
    if constexpr (!ALIGN_EPI) { if (wr == 0) PG8_BAR; }
    PG8_BAR;
    if constexpr (Epi::AFTER_DRAIN) { E.fused(acc, cur, wr, wc, fr, fq, lds, wid, lane); S.done(cur); }
#undef PG8_SA
#undef PG8_SB
#undef PG8_STAGE
#undef PG8_LDA
#undef PG8_LDB
#undef PG8_MMA
#undef PG8_WAIT_V
#undef PG8_WAIT_L
#undef PG8_BAR
#undef PG8_SCHED
}
}

constexpr int NB = 8, SEQ = 4096, DM = 1024, MTOK = NB * SEQ, DFF = 2816, NMEM = 256, NLAYER = 2;
constexpr int NHEAD = 6, DQK = 192, DV = 128, QW = NHEAD * DQK  , QP = 1280, KNW = NHEAD * 128  , HINW = 768;
constexpr float ALPHA_F = 1.4142135623730951f;
constexpr float LOG2E = 1.4426950408889634f;
constexpr int NWAVES = 8, NTHREADS = 512;

#define LAS __attribute__((address_space(3)))
typedef unsigned short bf16_t;
typedef short bf16x8 __attribute__((ext_vector_type(8)));
typedef float f32x4 __attribute__((ext_vector_type(4)));
typedef float f32x16 __attribute__((ext_vector_type(16)));
typedef float f32x2v __attribute__((ext_vector_type(2)));
typedef unsigned u32x4 __attribute__((ext_vector_type(4)));
typedef unsigned u32x2 __attribute__((ext_vector_type(2)));

constexpr size_t MiB = 1u << 20;
constexpr size_t WS_CTL = 0, CTL_ZERO_BYTES = 64 * 1024;
constexpr size_t OW_13A = 0, SZ_13 = (size_t)2 * DFF * DM * 2, OW_2A = OW_13A + SZ_13, SZ_2 = (size_t)DM * DFF * 2, OW_13B = OW_2A + SZ_2, OW_2B = OW_13B + SZ_13,
    OW_IN = OW_2B + SZ_2, SZ_IN = (size_t)HINW * DM * 2, OW_UQ = OW_IN + SZ_IN, SZ_UQ = (size_t)1280 * 256 * 2, OW_K = OW_UQ + SZ_UQ, SZ_K = (size_t)KNW * 128 * 2,
    OW_V = OW_K + SZ_K, OW_POOL = OW_V + SZ_K, SZ_POOL = (size_t)256 * 256 * 2, OW_OUT = OW_POOL + SZ_POOL, SZ_SQ = (size_t)DM * DM * 2, OW_MQ = OW_OUT + SZ_SQ,
    OW_MK = OW_MQ + SZ_SQ, OW_MV = OW_MK + SZ_SQ, OW_MO = OW_MV + SZ_SQ, LW_USED = OW_MO + SZ_SQ, LW = 46 * MiB;
static_assert(LW_USED <= LW, "weights per layer");
constexpr size_t WS_W = 1 * MiB, WS_MEMB = WS_W + 2 * LW  , WS_MEMK = WS_MEMB + 4 * MiB, WS_MEMVT = WS_MEMK + 8 * MiB, WS_CS = WS_MEMVT + 8 * MiB,
    WS_XN = WS_CS + 8 * MiB  , WS_Y = WS_XN + 64 * MiB  , WS_SH = WS_Y + 128 * MiB  , WS_END = WS_SH + 176 * MiB  ;
constexpr size_t WS_VT = WS_XN, WS_HIN = WS_Y, WS_Q = WS_Y, WS_KN = WS_Y + 80 * MiB;
constexpr size_t WS_H = WS_SH, WS_CQN = WS_SH, WS_CKVN = WS_SH + 16 * MiB, WS_KROT = WS_SH + 24 * MiB, WS_DPOOL = WS_SH + 28 * MiB, WS_YCAT = WS_SH + 44 * MiB;
constexpr size_t WS_QC = WS_SH, WS_OC = WS_SH + 64 * MiB;
static_assert((size_t)MTOK * QP * 2 <= 80 * MiB && WS_KN + (size_t)MTOK * KNW * 2 <= WS_SH && (size_t)MTOK * HINW * 4 <= 96 * MiB && WS_YCAT + (size_t)MTOK * DM * 2 <= WS_END && (size_t)MTOK * DFF * 2 <= 176 * MiB, "ws map");
constexpr int CW_QUEUE = 0, CW_BAR = 4096;

constexpr int RING_BYTES = 131072, MISC_OFF = RING_BYTES + 320, LDS_BYTES = 147456;

struct Params {
    const float* x; const float* mem; const int* pos; const float* ln_g; const float* ln_b; const float* ffn1_w13; const float* ffn1_w2; const float* w_in; const float* pool_w;
    const float* pool_scale; const float* q_norm_g; const float* w_uq; const float* kv_norm_g; const float* w_ukv; const float* w_out; const float* mem_wq; const float* mem_wkv;
    const float* mem_wo; const float* ffn2_w13; const float* ffn2_w2; float* out; unsigned char* ws;
};

__device__ __forceinline__ unsigned f2bf(float f) { unsigned u = __builtin_bit_cast(unsigned, f); return (u + 0x7fffu + ((u >> 16) & 1u)) >> 16; }
__device__ __forceinline__ unsigned pk2(float lo, float hi) { return f2bf(lo) | (f2bf(hi) << 16); }
__device__ __forceinline__ float wave_sum(float v) {
#pragma unroll
    for (int o = 1; o < 64; o <<= 1) v += __shfl_xor(v, o);
    return v;
}

enum { MAP_ID = 0, MAP_SWIGLU, MAP_WIN, MAP_WUQ, MAP_WK, MAP_WV, MAP_OFF1024 };
__device__ __forceinline__ int map_src(int kind, int n) {
    switch (kind) {
        case MAP_SWIGLU: { const int pn = n >> 8, bj = (n >> 7) & 1, c = n & 127; return bj * DFF + pn * 128 + c; }
        case MAP_WIN: { if (n < 640) return n; if (n >= 704) return -1; const int rho = n - 640; return 640 + (rho & 1) * 32 + (rho >> 1); }
        case MAP_WUQ: { if (n >= QW) return -1; const int hd = n / DQK, d = n % DQK; if (d < 128) return n; const int rho = d - 128; return hd * DQK + 128 + (rho & 1) * 32 + (rho >> 1); }
        case MAP_WK: { const int hd = n >> 7, d = n & 127; return hd * 256 + d; }
        case MAP_WV: { const int hd = n >> 7, d = n & 127; return hd * 256 + 128 + d; }
        case MAP_OFF1024: return n + 1024;
        default: return n;
    }
}
__device__ __forceinline__ void cvt_item(const float* W, int K, int Nsrc, bf16_t* WT, int nblk, int kind, const float* kscale, float scal, LAS float* scr, int item, int lane) {
    const int kb = item / nblk, nb = item % nblk, k0 = 64 * kb, n0 = 32 * nb;
    const int src = map_src(kind, n0 + (lane & 31));
#pragma unroll 8
    for (int i = 0; i < 32; ++i) { const int kk = 2 * i + (lane >> 5); float v = 0.f;
        if (src >= 0) { v = W[(size_t)(k0 + kk) * Nsrc + src] * scal; if (kscale) v *= kscale[k0 + kk]; }
        scr[kk * 33 + (lane & 31)] = v; }
    asm volatile("s_waitcnt lgkmcnt(0)" ::: "memory");
    const int c = lane & 7;
#pragma unroll
    for (int j = 0; j < 4; ++j) { const int n = (lane >> 3) + 8 * j; const LAS float* s = scr + (8 * c) * 33 + n;
        u32x4 o; o.x = pk2(s[0 * 33], s[1 * 33]); o.y = pk2(s[2 * 33], s[3 * 33]); o.z = pk2(s[4 * 33], s[5 * 33]); o.w = pk2(s[6 * 33], s[7 * 33]);
        *(u32x4*)(WT + (size_t)(n0 + n) * K + k0 + 8 * c) = o; }
    asm volatile("s_waitcnt lgkmcnt(0)" ::: "memory");
}

constexpr int IT_13 = 16 * 176, IT_2 = 44 * 32, IT_IN = 16 * 24, IT_UQ = 4 * 40, IT_K = 2 * 24, IT_SQ = 16 * 32;
constexpr int IT_LAYER = 2 * IT_13 + 2 * IT_2 + IT_IN + IT_UQ + 2 * IT_K + 5 * IT_SQ;

__device__ __forceinline__ void prologue(const Params& P, LAS unsigned char* lds, int gw, int NGW, int wave, int lane) {
    LAS float* scr = (LAS float*)(lds + wave * 16384);
    unsigned char* ws = P.ws;
    for (int it = gw; it < NLAYER * IT_LAYER; it += NGW) {
        const int l = it / IT_LAYER; int r = it % IT_LAYER; unsigned char* wl = ws + WS_W + (size_t)l * LW;
        if (r < IT_13) { cvt_item(P.ffn1_w13 + (size_t)l * DM * 2 * DFF, DM, 2 * DFF, (bf16_t*)(wl + OW_13A), 176, MAP_SWIGLU, nullptr, 1.f, scr, r, lane); continue; } r -= IT_13;
        if (r < IT_2) { cvt_item(P.ffn1_w2 + (size_t)l * DFF * DM, DFF, DM, (bf16_t*)(wl + OW_2A), 32, MAP_ID, nullptr, 1.f, scr, r, lane); continue; } r -= IT_2;
        if (r < IT_13) { cvt_item(P.ffn2_w13 + (size_t)l * DM * 2 * DFF, DM, 2 * DFF, (bf16_t*)(wl + OW_13B), 176, MAP_SWIGLU, nullptr, 1.f, scr, r, lane); continue; } r -= IT_13;
        if (r < IT_2) { cvt_item(P.ffn2_w2 + (size_t)l * DFF * DM, DFF, DM, (bf16_t*)(wl + OW_2B), 32, MAP_ID, nullptr, 1.f, scr, r, lane); continue; } r -= IT_2;
        if (r < IT_IN) { cvt_item(P.w_in + (size_t)l * DM * 704, DM, 704, (bf16_t*)(wl + OW_IN), 24, MAP_WIN, nullptr, 1.f, scr, r, lane); continue; } r -= IT_IN;
        if (r < IT_UQ) { cvt_item(P.w_uq + (size_t)l * 256 * QW, 256, QW, (bf16_t*)(wl + OW_UQ), 40, MAP_WUQ, P.q_norm_g + l * 256, 0.07216878364870322f * LOG2E, scr, r, lane); continue; } r -= IT_UQ;
        if (r < IT_K) { cvt_item(P.w_ukv + (size_t)l * 128 * 1536, 128, 1536, (bf16_t*)(wl + OW_K), 24, MAP_WK, P.kv_norm_g + l * 128, 1.f, scr, r, lane); continue; } r -= IT_K;
        if (r < IT_K) { cvt_item(P.w_ukv + (size_t)l * 128 * 1536, 128, 1536, (bf16_t*)(wl + OW_V), 24, MAP_WV, P.kv_norm_g + l * 128, 1.f, scr, r, lane); continue; } r -= IT_K;
        if (r < IT_SQ) { cvt_item(P.w_out + (size_t)l * DM * DM, DM, DM, (bf16_t*)(wl + OW_OUT), 32, MAP_ID, nullptr, 1.f, scr, r, lane); continue; } r -= IT_SQ;
        if (r < IT_SQ) { cvt_item(P.mem_wq + (size_t)l * DM * DM, DM, DM, (bf16_t*)(wl + OW_MQ), 32, MAP_ID, nullptr, 0.0625f * LOG2E, scr, r, lane); continue; } r -= IT_SQ;
        if (r < IT_SQ) { cvt_item(P.mem_wkv + (size_t)l * DM * 2 * DM, DM, 2 * DM, (bf16_t*)(wl + OW_MK), 32, MAP_ID, nullptr, 1.f, scr, r, lane); continue; } r -= IT_SQ;
        if (r < IT_SQ) { cvt_item(P.mem_wkv + (size_t)l * DM * 2 * DM, DM, 2 * DM, (bf16_t*)(wl + OW_MV), 32, MAP_OFF1024, nullptr, 1.f, scr, r, lane); continue; } r -= IT_SQ;
        cvt_item(P.mem_wo + (size_t)l * DM * DM, DM, DM, (bf16_t*)(wl + OW_MO), 32, MAP_ID, nullptr, 1.f, scr, r, lane);
    }
    const int gt = gw * 64 + lane, NGT = NGW * 64;
    for (int idx = gt; idx < NLAYER * 65536; idx += NGT) { const int l = idx >> 16, n = (idx >> 8) & 255, k = idx & 255; float v = 0.f;
        if ((n >> 6) == (k >> 6)) v = P.pool_w[(size_t)l * 16384 + (n >> 6) * 4096 + (k & 63) * 64 + (n & 63)] * P.pool_scale[l * 256 + n];
        ((bf16_t*)(ws + WS_W + (size_t)l * LW + OW_POOL))[n * 256 + k] = (bf16_t)f2bf(v); }
    { const f32x4* xs = (const f32x4*)P.x; u32x2* xd = (u32x2*)(ws + WS_XN);
      for (size_t i = gt; i < (size_t)MTOK * DM / 4; i += NGT) { const f32x4 v = xs[i]; u32x2 o; o.x = pk2(v[0], v[1]); o.y = pk2(v[2], v[3]); xd[i] = o; }
      const f32x4* ms = (const f32x4*)P.mem; u32x2* md = (u32x2*)(ws + WS_MEMB);
      for (size_t i = gt; i < (size_t)NB * NMEM * DM / 4; i += NGT) { const f32x4 v = ms[i]; u32x2 o; o.x = pk2(v[0], v[1]); o.y = pk2(v[2], v[3]); md[i] = o; } }
    { float* cs = (float*)(ws + WS_CS);
      for (int idx = gt; idx < MTOK * 32; idx += NGT) { const int m = idx >> 5, i = idx & 31;
        const float inv = (float)exp2(-(double)i * (13.287712379549449 / 32.0));
        const float ang = (float)P.pos[m] * inv;
        const double a = (double)ang; const double kq = rint(a * 0.15915494309189535); const double rr = fma(-kq, 6.283185307179586, a) - kq * 2.4492935982947064e-16;
        const float rf = (float)rr;
        f32x2v o; o.x = cosf(rf); o.y = sinf(rf); *(f32x2v*)(cs + (size_t)idx * 2) = o; } }
}

__device__ __forceinline__ void ln_pass(const float* Y, const float* g, const float* b, float* X, bf16_t* XN, int gw, int NGW, int lane) {
    f32x4 gv[4], bv[4];
#pragma unroll
    for (int j = 0; j < 4; ++j) { gv[j] = *(const f32x4*)(g + 256 * j + 4 * lane); bv[j] = *(const f32x4*)(b + 256 * j + 4 * lane); }
    for (int m = gw; m < MTOK; m += NGW) {
        const f32x4* yr = (const f32x4*)(Y + (size_t)m * DM) + lane; f32x4 v[4]; float s = 0.f;
#pragma unroll
        for (int j = 0; j < 4; ++j) { v[j] = yr[64 * j]; s += (v[j][0] + v[j][1]) + (v[j][2] + v[j][3]); }
        const float mean = wave_sum(s) * (1.f / DM); float s2 = 0.f;
#pragma unroll
        for (int j = 0; j < 4; ++j) { v[j] = v[j] - mean; s2 += (v[j][0] * v[j][0] + v[j][1] * v[j][1]) + (v[j][2] * v[j][2] + v[j][3] * v[j][3]); }
        const float rstd = 1.f / sqrtf(wave_sum(s2) * (1.f / DM) + 1e-5f);
        f32x4* xr = (f32x4*)(X + (size_t)m * DM) + lane; u32x2* nr = (u32x2*)(XN + (size_t)m * DM) + lane;
#pragma unroll
        for (int j = 0; j < 4; ++j) { const f32x4 o = v[j] * rstd * gv[j] + bv[j]; xr[64 * j] = o; u32x2 w; w.x = pk2(o[0], o[1]); w.y = pk2(o[2], o[3]); nr[64 * j] = w; }
    }
}
__device__ __forceinline__ void mid_pass(const float* HIN, const float* CS, bf16_t* DPOOL, bf16_t* CQN, bf16_t* CKVN, bf16_t* KROT, int gw, int NGW, int lane) {
    for (int m = gw; m < MTOK; m += NGW) {
        const int t = m & (SEQ - 1);
        const float* hr = HIN + (size_t)m * HINW;
        const f32x4 u = *(const f32x4*)(hr + 4 * lane), cq = *(const f32x4*)(hr + 256 + 4 * lane);
        f32x4 c2 = {0.f, 0.f, 0.f, 0.f}; if (lane < 48) c2 = *(const f32x4*)(hr + 512 + 4 * lane);
        { const int w = 2 << (lane >> 4); f32x4 a = u;
          for (int tau = 1; tau < 16; ++tau) if (tau < w && tau <= t) a += *(const f32x4*)(hr - (size_t)tau * HINW + 4 * lane);
          const float ic = 1.f / (float)((t + 1 < w) ? (t + 1) : w); const f32x4 d = a * ic - u;
          u32x2 o; o.x = pk2(d[0], d[1]); o.y = pk2(d[2], d[3]); *((u32x2*)(DPOOL + (size_t)m * 256) + lane) = o; }
        { const float ss = wave_sum((cq[0] * cq[0] + cq[1] * cq[1]) + (cq[2] * cq[2] + cq[3] * cq[3])); const float r = 1.f / sqrtf(ss * (1.f / 256.f) + 1e-6f);
          u32x2 o; o.x = pk2(cq[0] * r, cq[1] * r); o.y = pk2(cq[2] * r, cq[3] * r); *((u32x2*)(CQN + (size_t)m * 256) + lane) = o; }
        { const float sq = (lane < 32) ? (c2[0] * c2[0] + c2[1] * c2[1]) + (c2[2] * c2[2] + c2[3] * c2[3]) : 0.f;
          const float ss = wave_sum(sq); const float r = 1.f / sqrtf(ss * (1.f / 128.f) + 1e-6f);
          if (lane < 32) { u32x2 o; o.x = pk2(c2[0] * r, c2[1] * r); o.y = pk2(c2[2] * r, c2[3] * r); *((u32x2*)(CKVN + (size_t)m * 128) + lane) = o; }
          else if (lane < 48) { const int i0 = 2 * (lane - 32); const f32x4 cs = *(const f32x4*)(CS + ((size_t)m * 32 + i0) * 2);
            u32x2 o; o.x = pk2(c2[0] * cs[0] - c2[1] * cs[1], c2[1] * cs[0] + c2[0] * cs[1]); o.y = pk2(c2[2] * cs[2] - c2[3] * cs[3], c2[3] * cs[2] + c2[2] * cs[3]);
            *((u32x2*)(KROT + (size_t)m * 64) + (lane - 32)) = o; } }
    }
}

__device__ __forceinline__ int swap23(int r) { return (r & ~12) | ((r & 4) << 1) | ((r & 8) >> 1); }
template <int DQ>
__device__ __forceinline__ void attn_unit(LAS unsigned char* lds, const float* CSq, const bf16_t* Qw, int qpitch, const bf16_t* K1, int k1p, const bf16_t* K2, int k2p,
                                          const bf16_t* VT, int vtp, bf16_t* Ow, int opitch, int NT, int NTw) {
    constexpr int CH = DQ / 8, KP = DQ * 2 + 16, KB = 64 * KP, VP = 144, VB = 128 * VP, BUF = KB + VB, NKL = CH * 64 / NTHREADS, NKS = DQ / 16;
    static_assert(2 * BUF <= RING_BYTES && CH * 64 % NTHREADS == 0, "attention LDS");
    int tid = threadIdx.x; asm volatile("" : "+v"(tid));
    const int lane = tid & 63, r = lane & 31, h = lane >> 5;
    const bf16_t* kp[NKL]; int kst[NKL], kdst[NKL];
#pragma unroll
    for (int i = 0; i < NKL; ++i) { const int e = tid + NTHREADS * i, row = e / CH, c = e % CH;
        if (c < 16) { kp[i] = K1 + (size_t)row * k1p + c * 8; kst[i] = 64 * k1p; } else { kp[i] = K2 + (size_t)row * k2p + (c - 16) * 8; kst[i] = 64 * k2p; }
        kdst[i] = row * KP + c * 16; }
    const bf16_t* vp[2]; int vdst[2];
#pragma unroll
    for (int i = 0; i < 2; ++i) { const int e = tid + NTHREADS * i, row = e >> 3, c = e & 7; vp[i] = VT + (size_t)row * vtp + c * 8; vdst[i] = KB + row * VP + c * 16; }
    u32x4 kreg[NKL], vreg[2];
#define ATT_LOAD() do { _Pragma("unroll") for (int i = 0; i < NKL; ++i) { kreg[i] = *(const u32x4*)kp[i]; kp[i] += kst[i]; } \
                        _Pragma("unroll") for (int i = 0; i < 2; ++i) { vreg[i] = *(const u32x4*)vp[i]; vp[i] += 64; } } while (0)
#define ATT_STORE(buf) do { LAS unsigned char* b_ = lds + (buf) * BUF; _Pragma("unroll") for (int i = 0; i < NKL; ++i) *(LAS u32x4*)(b_ + kdst[i]) = kreg[i]; \
                        _Pragma("unroll") for (int i = 0; i < 2; ++i) *(LAS u32x4*)(b_ + vdst[i]) = vreg[i]; } while (0)
    ATT_LOAD();
    constexpr bool QREG = (DQ == 192);
    const bf16_t* qrow = Qw + (size_t)r * qpitch + h * 8;
    bf16x8 qf[QREG ? NKS : 1];
    if (QREG) {
#pragma unroll
        for (int ks = 0; ks < NKS; ++ks) qf[ks] = *(const bf16x8*)(qrow + ks * 16);
    }
    if (DQ == 192) {
#pragma unroll
        for (int ks = 8; ks < NKS; ++ks) { const float* cp = CSq + (size_t)r * 64 + ((ks - 8) * 8 + 4 * h) * 2; const f32x4 c0 = *(const f32x4*)cp, c1 = *(const f32x4*)(cp + 4);
            const float cc[4] = {c0[0], c0[2], c1[0], c1[2]}, sn[4] = {c0[1], c0[3], c1[1], c1[3]}; u32x4 w;
#pragma unroll
            for (int p = 0; p < 4; ++p) { const float x1 = __uint_as_float(((unsigned)(unsigned short)qf[ks][2 * p]) << 16), x2 = __uint_as_float(((unsigned)(unsigned short)qf[ks][2 * p + 1]) << 16);
                w[p] = pg8::cvt_pk_bf16(x1 * cc[p] - x2 * sn[p], x2 * cc[p] + x1 * sn[p]); }
            qf[ks] = __builtin_bit_cast(bf16x8, w); }
    }
    f32x16 o[4];
#pragma unroll
    for (int d = 0; d < 4; ++d)
#pragma unroll
        for (int i = 0; i < 16; ++i) o[d][i] = 0.f;
    float mrun = -1e30f, lrun = 0.f;
    ATT_STORE(0);
    __syncthreads();
    const int koff0 = swap23(r) * KP + h * 16, voff0 = KB + r * VP + h * 16;
    for (int t = 0; t < NT; ++t) {
        if (t + 1 < NT) ATT_LOAD();
        if (t < NTw) {
            const LAS unsigned char* kb = lds + (t & 1) * BUF;
            f32x16 s0, s1;
#pragma unroll
            for (int i = 0; i < 16; ++i) { s0[i] = 0.f; s1[i] = 0.f; }
#pragma unroll
            for (int ks = 0; ks < NKS; ++ks) {
                const bf16x8 a0 = *(const LAS bf16x8*)(kb + koff0 + ks * 32), a1 = *(const LAS bf16x8*)(kb + koff0 + 32 * KP + ks * 32);
                const bf16x8 qv = QREG ? qf[QREG ? ks : 0] : *(const bf16x8*)(qrow + ks * 16);
                s0 = __builtin_amdgcn_mfma_f32_32x32x16_bf16(a0, qv, s0, 0, 0, 0);
                s1 = __builtin_amdgcn_mfma_f32_32x32x16_bf16(a1, qv, s1, 0, 0, 0);
                if ((ks & 3) == 3) asm volatile("" ::: "memory");
            }
            float mx = fmaxf(s0[0], s1[0]);
#pragma unroll
            for (int i = 1; i < 16; ++i) mx = fmaxf(mx, fmaxf(s0[i], s1[i]));
            mx = fmaxf(mx, __shfl_xor(mx, 32));
            const float mnew = fmaxf(mrun, mx), alpha = __builtin_amdgcn_exp2f(mrun - mnew);
            mrun = mnew;
            float ls = 0.f;
#pragma unroll
            for (int i = 0; i < 16; ++i) { s0[i] = __builtin_amdgcn_exp2f(s0[i] - mnew); s1[i] = __builtin_amdgcn_exp2f(s1[i] - mnew); ls += s0[i] + s1[i]; }
            lrun = lrun * alpha + ls;
            if (__any(alpha != 1.0f)) {
#pragma unroll
                for (int d = 0; d < 4; ++d) o[d] = o[d] * alpha;
            }
            u32x4 pw[4];
#pragma unroll
            for (int s = 0; s < 2; ++s) {
                pw[s] = (u32x4){pg8::cvt_pk_bf16(s0[8 * s], s0[8 * s + 1]), pg8::cvt_pk_bf16(s0[8 * s + 2], s0[8 * s + 3]), pg8::cvt_pk_bf16(s0[8 * s + 4], s0[8 * s + 5]), pg8::cvt_pk_bf16(s0[8 * s + 6], s0[8 * s + 7])};
                pw[2 + s] = (u32x4){pg8::cvt_pk_bf16(s1[8 * s], s1[8 * s + 1]), pg8::cvt_pk_bf16(s1[8 * s + 2], s1[8 * s + 3]), pg8::cvt_pk_bf16(s1[8 * s + 4], s1[8 * s + 5]), pg8::cvt_pk_bf16(s1[8 * s + 6], s1[8 * s + 7])};
            }
#pragma unroll
            for (int kk = 0; kk < 4; ++kk) { const bf16x8 pb = __builtin_bit_cast(bf16x8, pw[kk]);
#pragma unroll
                for (int d = 0; d < 4; ++d) { const bf16x8 va = *(const LAS bf16x8*)(kb + voff0 + d * 32 * VP + kk * 32);
                    o[d] = __builtin_amdgcn_mfma_f32_32x32x16_bf16(va, pb, o[d], 0, 0, 0); }
                asm volatile("" ::: "memory"); }
        }
        if (t + 1 < NT) ATT_STORE((t + 1) & 1);
        __syncthreads();
    }
#undef ATT_LOAD
#undef ATT_STORE
    const float l = lrun + __shfl_xor(lrun, 32), il = 1.0f / l;
    bf16_t* orow = Ow + (size_t)r * opitch + 4 * h;
#pragma unroll
    for (int d = 0; d < 4; ++d)
#pragma unroll
        for (int g = 0; g < 4; ++g) { u32x2 w; w.x = pg8::cvt_pk_bf16(o[d][4 * g] * il, o[d][4 * g + 1] * il); w.y = pg8::cvt_pk_bf16(o[d][4 * g + 2] * il, o[d][4 * g + 3] * il);
            *(u32x2*)(orow + 32 * d + 8 * g) = w; }
}

#ifndef USE_XCD_BAR
#define USE_XCD_BAR 1
#endif
#define XB_TMO      128
#define XB_XCNT(j)  (256  + 64 * (j))
#define XB_XSUB(j)  (1280 + 64 * (j))
#define XB_XGEN(j)  (2304 + 64 * (j))
#define XB_TOP      3328
#define XB_TOPGEN   3392
#define XCD_BAR_WORDS 3456
#define XB_SPIN_CAP (1u << 18)

__device__ __forceinline__ unsigned xb_ld(unsigned* p)              { return __hip_atomic_load(p, __ATOMIC_RELAXED, __HIP_MEMORY_SCOPE_AGENT); }
__device__ __forceinline__ unsigned xb_add(unsigned* p, unsigned v) { return __hip_atomic_fetch_add(p, v, __ATOMIC_RELAXED, __HIP_MEMORY_SCOPE_AGENT); }
__device__ __forceinline__ unsigned xb_xcc_id() { return (unsigned)__builtin_amdgcn_s_getreg((3 << 11) | 20) & 0xFu; }
#define XB_SPIN(cond, bar) do { unsigned _sp = 0; while (cond) { __builtin_amdgcn_s_sleep(1); \
    if ((++_sp & 255u) == 0u) { if (xb_ld(&(bar)[XB_TMO])) break; if (_sp > XB_SPIN_CAP) { atomicAdd(&(bar)[XB_TMO], 1u); break; } } } } while (0)

struct XcdBarrier {
    unsigned* bar; unsigned x;
    volatile LAS unsigned* st;
};

__device__ __forceinline__ XcdBarrier xcd_barrier_post(unsigned* bar, volatile LAS unsigned* st) {
    XcdBarrier b; b.bar = bar; b.x = xb_xcc_id(); b.st = st;
    if (threadIdx.x == 0) (void)xb_add(&bar[XB_XCNT(b.x)], 1u);
    return b;
}
__device__ __forceinline__ void xcd_barrier_complete(unsigned* bar, unsigned x, unsigned& nloc, unsigned& nx) {
    const unsigned G = gridDim.x * gridDim.y * gridDim.z;
    unsigned sum, cnt, mine, sp = 0u;
    for (;;) {
        sum = 0u; cnt = 0u; mine = 0u;
#pragma unroll
        for (unsigned j = 0; j < 16; ++j) { const unsigned c = xb_ld(&bar[XB_XCNT(j)]); sum += c; cnt += (c > 0u) ? 1u : 0u; mine = (j == x) ? c : mine; }
        if (sum == G) break;
        __builtin_amdgcn_s_sleep(1);
        if ((++sp & 255u) == 0u) { if (xb_ld(&bar[XB_TMO])) break; if (sp > XB_SPIN_CAP) { atomicAdd(&bar[XB_TMO], 1u); break; } }
    }
    nloc = mine > 0u ? mine : 1u; nx = cnt > 0u ? cnt : 1u;
}

__device__ __forceinline__ void xcd_barrier(const XcdBarrier& b) {
    asm volatile("s_waitcnt vmcnt(0)" ::: "memory");
    __syncthreads();
    if (threadIdx.x == 0) {
        unsigned* bar = b.bar;
        __builtin_amdgcn_s_waitcnt(0);
        unsigned nloc = b.st[0], nx = b.st[1];
        if (nloc == 0u) { xcd_barrier_complete(bar, b.x, nloc, nx); b.st[0] = nloc; b.st[1] = nx; }
        const unsigned old = xb_add(&bar[XB_XSUB(b.x)], 1u);
        const unsigned gen = old / nloc;
        if (old + 1u == (gen + 1u) * nloc) {
            __builtin_amdgcn_fence(__ATOMIC_RELEASE, "agent");
            asm volatile("s_waitcnt vmcnt(0)" ::: "memory");
            const unsigned og = xb_add(&bar[XB_TOP], 1u);
            const unsigned tg = og / nx;
            if (og + 1u == (tg + 1u) * nx) xb_add(&bar[XB_TOPGEN], 1u);
            else XB_SPIN(xb_ld(&bar[XB_TOPGEN]) == tg, bar);
            __builtin_amdgcn_fence(__ATOMIC_ACQUIRE, "agent");
            xb_add(&bar[XB_XGEN(b.x)], 1u);
            asm volatile("s_waitcnt vmcnt(0)" ::: "memory");
        } else {
            XB_SPIN(xb_ld(&bar[XB_XGEN(b.x)]) == gen, bar);
            __builtin_amdgcn_fence(__ATOMIC_ACQUIRE, "agent");
            asm volatile("s_waitcnt vmcnt(0)" ::: "memory");
        }
    }
    __syncthreads();
}

enum { K_UP = 0, K_RES, K_LN, K_IN, K_MID, K_QKV, K_ATTN, K_CQ, K_CATTN, K_EONLY };

__global__ void __launch_bounds__(NTHREADS, 2) fwd_kernel(Params P) {
    extern __shared__ __attribute__((aligned(16))) unsigned char lds_raw[];
    LAS unsigned char* lds = (LAS unsigned char*)lds_raw;
    cg::grid_group grid = cg::this_grid();
    const int tid0 = threadIdx.x;
    for (int u = tid0; u < (LDS_BYTES - RING_BYTES) / 4; u += NTHREADS) ((LAS unsigned*)(lds + RING_BYTES))[u] = 0u;
    __syncthreads();
    volatile LAS unsigned* MISC = (volatile LAS unsigned*)(lds + MISC_OFF);
#if USE_XCD_BAR
    (void)xcd_barrier_post((unsigned*)(P.ws + WS_CTL) + CW_BAR, MISC + 8);
#define GSYNC() do { const __attribute__((address_space(4))) Params* pq = (const __attribute__((address_space(4))) Params*)__builtin_amdgcn_kernarg_segment_ptr(); asm volatile("" : "+s"(pq)); \
        XcdBarrier bar; bar.bar = (unsigned*)(pq->ws + WS_CTL) + CW_BAR; bar.x = xb_xcc_id(); bar.st = MISC + 8; xcd_barrier(bar); } while (0)
#else
#define GSYNC() grid.sync()
#endif
#define WSP(T, off) ((T*)(ws + (off)))
#define XN WSP(bf16_t, WS_XN)
#define Y WSP(float, WS_Y)
#define H WSP(bf16_t, WS_H)
#define HIN WSP(float, WS_HIN)
#define Qb WSP(bf16_t, WS_Q)
#define KN WSP(bf16_t, WS_KN)
#define VT WSP(bf16_t, WS_VT)
#define CQN WSP(bf16_t, WS_CQN)
#define CKVN WSP(bf16_t, WS_CKVN)
#define KROT WSP(bf16_t, WS_KROT)
#define DPOOL WSP(bf16_t, WS_DPOOL)
#define YCAT WSP(bf16_t, WS_YCAT)
#define QC WSP(bf16_t, WS_QC)
#define OC WSP(bf16_t, WS_OC)
#define MEMB WSP(bf16_t, WS_MEMB)
#define CS WSP(const float, WS_CS)
    { const int wave = __builtin_amdgcn_readfirstlane(tid0 >> 6); prologue(P, lds, blockIdx.x * NWAVES + wave, gridDim.x * NWAVES, wave, tid0 & 63); }
    grid.sync();

#define PHASE_BEGIN { constexpr int l = LCONST; (void)l; int tid = threadIdx.x; asm volatile("" : "+v"(tid)); const int lane = tid & 63, wave = __builtin_amdgcn_readfirstlane(tid >> 6); (void)lane; (void)wave; const int G = gridDim.x, gw = blockIdx.x * NWAVES + wave, NGW = G * NWAVES; (void)gw; (void)NGW; \
        const __attribute__((address_space(4))) Params* pp = (const __attribute__((address_space(4))) Params*)__builtin_amdgcn_kernarg_segment_ptr(); asm volatile("" : "+s"(pp)); \
        unsigned char* ws = pp->ws; unsigned char* wl = ws + WS_W + (size_t)l * LW; (void)wl;
#define PHASE_END_SYNC } GSYNC();
#define PHASE_END_NOSYNC } __syncthreads();
#define RUN_GEMM(EPI, M_, N_, K_, Aptr, Bptr, ...) do { pg8::Gemm g{(const bf16_t*)(Aptr), (const bf16_t*)(Bptr), M_, N_, K_}; pg8::StaticOrder S; S.init(M_, N_, G, (int)blockIdx.x); \
            pg8::EPI E{__VA_ARGS__}; pg8::gemm_phase<pg8::EPI, pg8::StaticOrder, true, true>(lds, g, S, E); } while (0)
#define RUN_GEMM_RK(EPI, M_, N_, K_, Aptr, Bptr, ...) do { int Kr = K_; asm volatile("" : "+s"(Kr)); pg8::Gemm g{(const bf16_t*)(Aptr), (const bf16_t*)(Bptr), M_, N_, Kr}; pg8::StaticOrder S; S.init(M_, N_, G, (int)blockIdx.x); \
            pg8::EPI E{__VA_ARGS__}; pg8::gemm_phase<pg8::EPI, pg8::StaticOrder, true, false>(lds, g, S, E); } while (0)
#define LN_PHASE_LAST(i) PHASE_BEGIN ln_pass(Y, pp->ln_g + (size_t)(l * 4 + (i)) * DM, pp->ln_b + (size_t)(l * 4 + (i)) * DM, pp->out, XN, gw, NGW, lane); }
#define LN_PHASE(i) PHASE_BEGIN ln_pass(Y, pp->ln_g + (size_t)(l * 4 + (i)) * DM, pp->ln_b + (size_t)(l * 4 + (i)) * DM, pp->out, XN, gw, NGW, lane); PHASE_END_SYNC

#define LCONST 0
    PHASE_BEGIN RUN_GEMM(EpiBf16, NB * NMEM, DM, DM, MEMB, ws + WS_W + OW_MK, (bf16_t*)(ws + WS_MEMK), DM); PHASE_END_NOSYNC
    PHASE_BEGIN RUN_GEMM(EpiBf16, DM, NB * NMEM, DM, ws + WS_W + OW_MV, MEMB, (bf16_t*)(ws + WS_MEMVT), NB * NMEM); PHASE_END_NOSYNC
    PHASE_BEGIN RUN_GEMM(EpiBf16, NB * NMEM, DM, DM, MEMB, ws + WS_W + LW + OW_MK, (bf16_t*)(ws + WS_MEMK + 4 * MiB), DM); PHASE_END_NOSYNC
    PHASE_BEGIN RUN_GEMM(EpiBf16, DM, NB * NMEM, DM, ws + WS_W + LW + OW_MV, MEMB, (bf16_t*)(ws + WS_MEMVT + 4 * MiB), NB * NMEM); PHASE_END_NOSYNC

        PHASE_BEGIN RUN_GEMM(EpiSwiGLU, MTOK, 2 * DFF, DM, XN, wl + OW_13A, H, DFF); PHASE_END_SYNC
        PHASE_BEGIN RUN_GEMM(EpiRes, MTOK, DM, DFF, H, wl + OW_2A, (l == 0) ? pp->x : pp->out, Y, DM, ALPHA_F, 0.5f); PHASE_END_SYNC
        LN_PHASE(0)
        PHASE_BEGIN RUN_GEMM(EpiF32, MTOK, HINW, DM, XN, wl + OW_IN, HIN, HINW); PHASE_END_SYNC
        PHASE_BEGIN mid_pass(HIN, CS, DPOOL, CQN, CKVN, KROT, gw, NGW, lane); PHASE_END_SYNC
        PHASE_BEGIN RUN_GEMM_RK(EpiBf16, MTOK, QP, 256, CQN, wl + OW_UQ, Qb, QP); PHASE_END_NOSYNC
        PHASE_BEGIN RUN_GEMM_RK(EpiBf16, MTOK, KNW, 128, CKVN, wl + OW_K, KN, KNW); PHASE_END_NOSYNC
        PHASE_BEGIN RUN_GEMM_RK(EpiBf16, KNW, MTOK, 128, wl + OW_V, CKVN, VT, MTOK); PHASE_END_NOSYNC
        PHASE_BEGIN RUN_GEMM_RK(EpiBf16, MTOK, 256, 256, DPOOL, wl + OW_POOL, YCAT, DM); PHASE_END_SYNC
        PHASE_BEGIN
            unsigned* qctr = (unsigned*)(ws + WS_CTL) + CW_QUEUE + 64 * l;
            for (;;) {
                if (tid == 0) MISC[0] = atomicAdd(qctr, 1u);
                __syncthreads();
                const int u = __builtin_amdgcn_readfirstlane((int)MISC[0]);
                __syncthreads();
                if (u >= NB * NHEAD * 16) break;
                const int qb = 15 - u / 48, bh = u % 48, b = bh / 6, hd = bh % 6;
                const size_t tok0 = (size_t)b * SEQ, tq = tok0 + qb * 256 + wave * 32;
                attn_unit<192>(lds, CS + tq * 64, Qb + tq * QP + hd * DQK, QP, KN + tok0 * KNW + hd * 128, KNW, KROT + tok0 * 64, 64, VT + (size_t)(hd * 128) * MTOK + tok0, MTOK,
                               YCAT + tq * DM + 256 + hd * 128, DM, 4 * qb + 4, 4 * qb + (wave >> 1) + 1);
            }
        PHASE_END_SYNC
        PHASE_BEGIN RUN_GEMM(EpiRes, MTOK, DM, DM, YCAT, wl + OW_OUT, pp->out, Y, DM, ALPHA_F, 1.0f); PHASE_END_SYNC
        LN_PHASE(1)
        PHASE_BEGIN RUN_GEMM(EpiBf16, MTOK, DM, DM, XN, wl + OW_MQ, QC, DM); PHASE_END_SYNC
        PHASE_BEGIN
            const bf16_t* MEMK = (const bf16_t*)(ws + WS_MEMK + (size_t)l * 4 * MiB); const bf16_t* MEMVT = (const bf16_t*)(ws + WS_MEMVT + (size_t)l * 4 * MiB);
            for (int u = blockIdx.x; u < NB * 4 * 16 * 2; u += G) {
                const int half = u & 1, qb = (u >> 1) & 15, bh = u >> 5, b = bh >> 2, hd = bh & 3;
                const size_t tq = (size_t)b * SEQ + qb * 256 + wave * 32;
                const bf16_t* k1 = MEMK + (size_t)(b * NMEM) * DM + hd * 256;
                attn_unit<256>(lds, nullptr, QC + tq * DM + hd * 256, DM, k1, DM, k1 + 128, DM, MEMVT + (size_t)(hd * 256 + half * 128) * (NB * NMEM) + b * NMEM, NB * NMEM,
                               OC + tq * DM + hd * 256 + half * 128, DM, 4, 4);
            }
        PHASE_END_SYNC
        PHASE_BEGIN RUN_GEMM(EpiRes, MTOK, DM, DM, OC, wl + OW_MO, pp->out, Y, DM, ALPHA_F, 1.0f); PHASE_END_SYNC
        LN_PHASE(2)
        PHASE_BEGIN RUN_GEMM(EpiSwiGLU, MTOK, 2 * DFF, DM, XN, wl + OW_13B, H, DFF); PHASE_END_SYNC
        PHASE_BEGIN RUN_GEMM(EpiRes, MTOK, DM, DFF, H, wl + OW_2B, pp->out, Y, DM, ALPHA_F, 0.5f); PHASE_END_SYNC
        LN_PHASE(3)
#undef LCONST
#define LCONST 1
        PHASE_BEGIN RUN_GEMM(EpiSwiGLU, MTOK, 2 * DFF, DM, XN, wl + OW_13A, H, DFF); PHASE_END_SYNC
        PHASE_BEGIN RUN_GEMM(EpiRes, MTOK, DM, DFF, H, wl + OW_2A, (l == 0) ? pp->x : pp->out, Y, DM, ALPHA_F, 0.5f); PHASE_END_SYNC
        LN_PHASE(0)
        PHASE_BEGIN RUN_GEMM(EpiF32, MTOK, HINW, DM, XN, wl + OW_IN, HIN, HINW); PHASE_END_SYNC
        PHASE_BEGIN mid_pass(HIN, CS, DPOOL, CQN, CKVN, KROT, gw, NGW, lane); PHASE_END_SYNC
        PHASE_BEGIN RUN_GEMM_RK(EpiBf16, MTOK, QP, 256, CQN, wl + OW_UQ, Qb, QP); PHASE_END_NOSYNC
        PHASE_BEGIN RUN_GEMM_RK(EpiBf16, MTOK, KNW, 128, CKVN, wl + OW_K, KN, KNW); PHASE_END_NOSYNC
        PHASE_BEGIN RUN_GEMM_RK(EpiBf16, KNW, MTOK, 128, wl + OW_V, CKVN, VT, MTOK); PHASE_END_NOSYNC
        PHASE_BEGIN RUN_GEMM_RK(EpiBf16, MTOK, 256, 256, DPOOL, wl + OW_POOL, YCAT, DM); PHASE_END_SYNC
        PHASE_BEGIN
            unsigned* qctr = (unsigned*)(ws + WS_CTL) + CW_QUEUE + 64 * l;
            for (;;) {
                if (tid == 0) MISC[0] = atomicAdd(qctr, 1u);
                __syncthreads();
                const int u = __builtin_amdgcn_readfirstlane((int)MISC[0]);
                __syncthreads();
                if (u >= NB * NHEAD * 16) break;
                const int qb = 15 - u / 48, bh = u % 48, b = bh / 6, hd = bh % 6;
                const size_t tok0 = (size_t)b * SEQ, tq = tok0 + qb * 256 + wave * 32;
                attn_unit<192>(lds, CS + tq * 64, Qb + tq * QP + hd * DQK, QP, KN + tok0 * KNW + hd * 128, KNW, KROT + tok0 * 64, 64, VT + (size_t)(hd * 128) * MTOK + tok0, MTOK,
                               YCAT + tq * DM + 256 + hd * 128, DM, 4 * qb + 4, 4 * qb + (wave >> 1) + 1);
            }
        PHASE_END_SYNC
        PHASE_BEGIN RUN_GEMM(EpiRes, MTOK, DM, DM, YCAT, wl + OW_OUT, pp->out, Y, DM, ALPHA_F, 1.0f); PHASE_END_SYNC
        LN_PHASE(1)
        PHASE_BEGIN RUN_GEMM(EpiBf16, MTOK, DM, DM, XN, wl + OW_MQ, QC, DM); PHASE_END_SYNC
        PHASE_BEGIN
            const bf16_t* MEMK = (const bf16_t*)(ws + WS_MEMK + (size_t)l * 4 * MiB); const bf16_t* MEMVT = (const bf16_t*)(ws + WS_MEMVT + (size_t)l * 4 * MiB);
            for (int u = blockIdx.x; u < NB * 4 * 16 * 2; u += G) {
                const int half = u & 1, qb = (u >> 1) & 15, bh = u >> 5, b = bh >> 2, hd = bh & 3;
                const size_t tq = (size_t)b * SEQ + qb * 256 + wave * 32;
                const bf16_t* k1 = MEMK + (size_t)(b * NMEM) * DM + hd * 256;
                attn_unit<256>(lds, nullptr, QC + tq * DM + hd * 256, DM, k1, DM, k1 + 128, DM, MEMVT + (size_t)(hd * 256 + half * 128) * (NB * NMEM) + b * NMEM, NB * NMEM,
                               OC + tq * DM + hd * 256 + half * 128, DM, 4, 4);
            }
        PHASE_END_SYNC
        PHASE_BEGIN RUN_GEMM(EpiRes, MTOK, DM, DM, OC, wl + OW_MO, pp->out, Y, DM, ALPHA_F, 1.0f); PHASE_END_SYNC
        LN_PHASE(2)
        PHASE_BEGIN RUN_GEMM(EpiSwiGLU, MTOK, 2 * DFF, DM, XN, wl + OW_13B, H, DFF); PHASE_END_SYNC
        PHASE_BEGIN RUN_GEMM(EpiRes, MTOK, DM, DFF, H, wl + OW_2B, pp->out, Y, DM, ALPHA_F, 0.5f); PHASE_END_SYNC
        LN_PHASE_LAST(3)
#undef LCONST
}

extern "C" void kernel_launch(void* const* d_in, const int* in_sizes, int n_in, void* d_out, int out_size, void* d_ws, size_t ws_size, hipStream_t stream) {
    static int grid = 0;
    if (grid == 0) {
        if (n_in != 20 || in_sizes[0] != MTOK * DM || out_size != MTOK * DM || ws_size < WS_END) {
            fprintf(stderr, "kernel_launch: unexpected shapes (n_in %d, in0 %d, out %d, ws %zu < %zu)\n", n_in, n_in > 0 ? in_sizes[0] : -1, out_size, ws_size, (size_t)WS_END); grid = -1; return; }
        int dev = 0, cus = 0, per_cu = 0;
        hipGetDevice(&dev); hipDeviceGetAttribute(&cus, hipDeviceAttributeMultiprocessorCount, dev);
        if (hipFuncSetAttribute((const void*)fwd_kernel, hipFuncAttributeMaxDynamicSharedMemorySize, LDS_BYTES) != hipSuccess) { fprintf(stderr, "kernel_launch: hipFuncSetAttribute failed\n"); grid = -1; return; }
        if (hipOccupancyMaxActiveBlocksPerMultiprocessor(&per_cu, (const void*)fwd_kernel, NTHREADS, LDS_BYTES) != hipSuccess || per_cu < 1) per_cu = 1;
        (void)hipGetLastError();
        if (per_cu > 1) per_cu = 1;
        grid = cus * per_cu;
    }
    if (grid < 0) return;
    hipMemsetAsync((char*)d_ws + WS_CTL, 0, CTL_ZERO_BYTES, stream);
    Params p{};
    p.x = (const float*)d_in[0]; p.mem = (const float*)d_in[1]; p.pos = (const int*)d_in[2]; p.ln_g = (const float*)d_in[3]; p.ln_b = (const float*)d_in[4];
    p.ffn1_w13 = (const float*)d_in[5]; p.ffn1_w2 = (const float*)d_in[6]; p.w_in = (const float*)d_in[7]; p.pool_w = (const float*)d_in[8]; p.pool_scale = (const float*)d_in[9];
    p.q_norm_g = (const float*)d_in[10]; p.w_uq = (const float*)d_in[11]; p.kv_norm_g = (const float*)d_in[12]; p.w_ukv = (const float*)d_in[13]; p.w_out = (const float*)d_in[14];
    p.mem_wq = (const float*)d_in[15]; p.mem_wkv = (const float*)d_in[16]; p.mem_wo = (const float*)d_in[17]; p.ffn2_w13 = (const float*)d_in[18]; p.ffn2_w2 = (const float*)d_in[19];
    p.out = (float*)d_out; p.ws = (unsigned char*)d_ws;
    void* args[] = {&p};
    hipError_t e = hipLaunchCooperativeKernel((const void*)fwd_kernel, dim3(grid), dim3(NTHREADS), args, LDS_BYTES, stream);
    if (e != hipSuccess) fprintf(stderr, "kernel_launch: cooperative launch failed: %s (grid %d)\n", hipGetErrorString(e), grid);
}
```
